# Optimizing an MI355X kernel written in HIP

```python
import math
import jax, jax.numpy as jnp
from jax import lax
import numpy as np

D_MODEL = 2048
BATCH = 4
SEQ = 2048
DEPTH = 2

HEAD_DIM = 64
N_MIXERS = 4
GROUP_WIDTH = D_MODEL // N_MIXERS
N_FOX_HEADS = GROUP_WIDTH // HEAD_DIM
N_SB_HEADS = GROUP_WIDTH // HEAD_DIM
N_DIFF_HEADS = GROUP_WIDTH // (2 * HEAD_DIM)
N_DIL_HEADS = GROUP_WIDTH // HEAD_DIM
MIX_WIDTH = N_MIXERS * GROUP_WIDTH
D_FF = 4 * D_MODEL
QUERY_BLOCK = 128
DILATED_BRANCHES = ((128, 1), (512, 4), (2048, 16))
ALIBI_MAX_EXP = 8.0
LN_EPS = 1e-5
RMS_EPS = 1e-5
FORGET_BIAS_INIT = 2.0
DEEPNORM_ALPHA = (2 * DEPTH) ** 0.25
DEEPNORM_BETA = (8 * DEPTH) ** -0.25
IN_SPLITS = (GROUP_WIDTH,) * 3 + (N_FOX_HEADS,) + (GROUP_WIDTH,) * 9
IN_WIDTH = 12 * GROUP_WIDTH + N_FOX_HEADS
V_SEGMENTS = (2, 6, 9, 12)

kernel_name = "hybrid_fox_stickbreak_diff_dilated_deepnorm"


def _layer_norm(x, g, b):
    xf = x.astype(jnp.float32)
    mu = jnp.mean(xf, axis=-1, keepdims=True)
    var = jnp.mean(jnp.square(xf - mu), axis=-1, keepdims=True)
    return ((xf - mu) * lax.rsqrt(var + LN_EPS) * g + b).astype(x.dtype)


def _alibi_slopes():
    n = N_DIFF_HEADS + N_DIL_HEADS
    return jnp.exp2(-ALIBI_MAX_EXP * jnp.arange(1, n + 1, dtype=jnp.float32) / n)


def _heads(a, n):
    B, S, _ = a.shape
    return a.reshape(B, S, n, -1).transpose(0, 2, 1, 3)


def _merge_heads(o):
    B, H, S, d = o.shape
    return o.transpose(0, 2, 1, 3).reshape(B, S, H * d)


def _to_query_blocks(a):
    B, H, S = a.shape[:3]
    a = a.reshape(B, H, S // QUERY_BLOCK, QUERY_BLOCK, *a.shape[3:])
    return jnp.moveaxis(a, 2, 0)


def _from_query_blocks(o):
    nb, B, H, qb = o.shape[:4]
    return jnp.moveaxis(o, 0, 2).reshape(B, H, nb * qb, *o.shape[4:])


def _query_positions(S):
    return jnp.arange(S).reshape(S // QUERY_BLOCK, QUERY_BLOCK)


def _forgetting_attention(q, k, v, log_f_cum):
    S = q.shape[2]
    scale = q.shape[-1] ** -0.5
    kpos = jnp.arange(S)

    def block(args):
        qb, cb, tq = args
        s = jnp.einsum('bhqd,bhkd->bhqk', qb, k).astype(jnp.float32) * scale
        s = s + cb[..., None] - log_f_cum[:, :, None, :]
        s = jnp.where(kpos[None, :] <= tq[:, None], s, -jnp.inf)
        p = jax.nn.softmax(s, axis=-1)
        return jnp.einsum('bhqk,bhkd->bhqd', p.astype(v.dtype), v)

    out = lax.map(block, (_to_query_blocks(q), _to_query_blocks(log_f_cum), _query_positions(S)))
    return _from_query_blocks(out)


def _stick_breaking_attention(q, k, v):
    S = q.shape[2]
    scale = q.shape[-1] ** -0.5
    kpos = jnp.arange(S)

    def block(args):
        qb, tq = args
        z = jnp.einsum('bhqd,bhkd->bhqk', qb, k).astype(jnp.float32) * scale
        strict = kpos[None, :] < tq[:, None]
        log_beta = jax.nn.log_sigmoid(z)
        log_one_minus = jnp.where(strict, jax.nn.log_sigmoid(-z), 0.0)
        later = lax.cumsum(log_one_minus, axis=3, reverse=True) - log_one_minus
        a = jnp.where(strict, jnp.exp(log_beta + later), 0.0)
        return jnp.einsum('bhqk,bhkd->bhqd', a.astype(v.dtype), v)

    out = lax.map(block, (_to_query_blocks(q), _query_positions(S)))
    return _from_query_blocks(out)


def _differential_attention(q1, q2, k1, k2, v, lam, slopes):
    S = q1.shape[2]
    scale = q1.shape[-1] ** -0.5
    kpos = jnp.arange(S)

    def block(args):
        q1b, q2b, tq = args
        dist = tq[:, None] - kpos[None, :]
        causal = dist >= 0
        bias = -slopes[:, None, None] * dist.astype(jnp.float32)

        def probs(qb, kk):
            s = jnp.einsum('bhqd,bhkd->bhqk', qb, kk).astype(jnp.float32) * scale + bias
            return jax.nn.softmax(jnp.where(causal, s, -jnp.inf), axis=-1)

        a = probs(q1b, k1) - lam * probs(q2b, k2)
        return jnp.einsum('bhqk,bhkd->bhqd', a.astype(v.dtype), v)

    out = lax.map(block, (_to_query_blocks(q1), _to_query_blocks(q2), _query_positions(S)))
    return _from_query_blocks(out)


def _dilated_branch(q, k, v, slopes, window, dilation):
    B, S, H, d = q.shape
    n = window // dilation
    unit = n * dilation
    Lp = -(-S // unit) * unit
    nb = Lp // unit

    def to_blocks(a):
        a = jnp.pad(a, ((0, 0), (0, Lp - S), (0, 0), (0, 0)))
        a = a.reshape(B, Lp // dilation, dilation, H, d).transpose(0, 2, 3, 1, 4)
        return a.reshape(B, dilation, H, nb, n, d)

    def with_prev(a):
        prev = jnp.concatenate([jnp.zeros_like(a[:, :, :, :1]), a[:, :, :, :-1]], axis=3)
        return jnp.concatenate([prev, a], axis=4)

    qb = to_blocks(q)
    kk = with_prev(to_blocks(k))
    vv = with_prev(to_blocks(v))
    s = jnp.einsum('brhnqd,brhnkd->brhnqk', qb, kk).astype(jnp.float32) * d ** -0.5
    i = jnp.arange(n)[:, None]
    j = jnp.arange(2 * n)[None, :]
    steps = n + i - j
    in_band = (steps >= 0) & (steps <= n)
    has_key = (jnp.arange(nb)[:, None, None] > 0) | (j[None] >= n)
    valid = in_band[None] & has_key
    s = s - slopes[:, None, None, None] * (steps * dilation).astype(jnp.float32)
    s = jnp.where(valid, s, -jnp.inf)
    m = jnp.max(s, axis=-1, keepdims=True)
    e = jnp.exp(s - m)
    denom = jnp.sum(e, axis=-1, keepdims=True)
    o = jnp.einsum('brhnqk,brhnkd->brhnqd', (e / denom).astype(v.dtype), vv)
    lse = (m + jnp.log(denom))[..., 0]

    def from_blocks(a):
        rest = a.shape[5:]
        a = a.reshape(B, dilation, H, Lp // dilation, *rest)
        perm = (0, 3, 1, 2) + tuple(range(4, a.ndim))
        return a.transpose(perm).reshape(B, Lp, H, *rest)[:, :S]

    return from_blocks(o), from_blocks(lse)


def _dilated_attention(q, k, v, slopes):
    outs, lses = [], []
    for window, dilation in DILATED_BRANCHES:
        o, lse = _dilated_branch(q, k, v, slopes, window, dilation)
        outs.append(o)
        lses.append(lse)
    w = jax.nn.softmax(jnp.stack(lses), axis=0)
    o = jnp.sum(w[..., None] * jnp.stack(outs).astype(jnp.float32), axis=0)
    return o.astype(v.dtype)


def _hybrid_layer(x, layer_idx, w_in, b_f, lq1, lk1, lq2, lk2, subln_g, w_out,
                  ln1_g, ln1_b, w1, w2, ln2_g, ln2_b):
    B, S, _ = x.shape
    h = jnp.einsum('bsd,de->bse', x, w_in)
    parts = jnp.split(h, np.cumsum(IN_SPLITS)[:-1].tolist(), axis=-1)
    fq, fk, fv, fz, sq, sk, sv, dq, dk, dv, gq, gk, gv = parts
    slopes = _alibi_slopes()

    log_f = jax.nn.log_sigmoid(fz.astype(jnp.float32) + b_f.astype(jnp.float32))
    log_f_cum = jnp.cumsum(log_f, axis=1).transpose(0, 2, 1)
    o_fox = _forgetting_attention(_heads(fq, N_FOX_HEADS), _heads(fk, N_FOX_HEADS),
                                  _heads(fv, N_FOX_HEADS), log_f_cum)

    o_sb = _stick_breaking_attention(_heads(sq, N_SB_HEADS), _heads(sk, N_SB_HEADS),
                                     _heads(sv, N_SB_HEADS))

    dq = dq.reshape(B, S, N_DIFF_HEADS, 2, HEAD_DIM).transpose(0, 2, 3, 1, 4)
    dk = dk.reshape(B, S, N_DIFF_HEADS, 2, HEAD_DIM).transpose(0, 2, 3, 1, 4)
    lam_init = 0.8 - 0.6 * math.exp(-0.3 * layer_idx)
    lam = (jnp.exp(jnp.sum(lq1.astype(jnp.float32) * lk1.astype(jnp.float32)))
           - jnp.exp(jnp.sum(lq2.astype(jnp.float32) * lk2.astype(jnp.float32))) + lam_init)
    od = _differential_attention(dq[:, :, 0], dq[:, :, 1], dk[:, :, 0], dk[:, :, 1],
                                 _heads(dv, N_DIFF_HEADS), lam, slopes[:N_DIFF_HEADS])
    odf = od.astype(jnp.float32)
    odf = odf * lax.rsqrt(jnp.mean(jnp.square(odf), axis=-1, keepdims=True) + RMS_EPS)
    o_diff = (odf * subln_g * (1.0 - lam_init)).astype(x.dtype)

    o_dil = _dilated_attention(gq.reshape(B, S, N_DIL_HEADS, HEAD_DIM),
                               gk.reshape(B, S, N_DIL_HEADS, HEAD_DIM),
                               gv.reshape(B, S, N_DIL_HEADS, HEAD_DIM),
                               slopes[N_DIFF_HEADS:])

    mixed = jnp.concatenate([_merge_heads(o_fox), _merge_heads(o_sb), _merge_heads(o_diff),
                             o_dil.reshape(B, S, -1)], axis=-1)
    y = jnp.einsum('bse,ed->bsd', mixed, w_out)
    x = _layer_norm(DEEPNORM_ALPHA * x + y, ln1_g, ln1_b)

    a = jax.nn.relu(jnp.einsum('bsd,df->bsf', x, w1))
    y = jnp.einsum('bsf,fd->bsd', a * a, w2)
    return _layer_norm(DEEPNORM_ALPHA * x + y, ln2_g, ln2_b)


def setup_inputs(seed: int = 0) -> dict:
    key = jax.random.key(seed)
    ks = jax.random.split(key, 16)
    nrm = jax.random.normal
    col_scale = np.ones((IN_WIDTH,), np.float32)
    off = np.concatenate([[0], np.cumsum(IN_SPLITS)])
    for seg in V_SEGMENTS:
        col_scale[off[seg]:off[seg + 1]] = DEEPNORM_BETA
    x = nrm(ks[0], (BATCH, SEQ, D_MODEL), jnp.float32)
    w_in = nrm(ks[1], (DEPTH, D_MODEL, IN_WIDTH), jnp.float32) * (D_MODEL ** -0.5) * jnp.asarray(col_scale)
    fox_forget_bias = FORGET_BIAS_INIT + 0.1 * nrm(ks[2], (DEPTH, N_FOX_HEADS), jnp.float32)
    diff_lambda_q1 = 0.1 * nrm(ks[3], (DEPTH, HEAD_DIM), jnp.float32)
    diff_lambda_k1 = 0.1 * nrm(ks[4], (DEPTH, HEAD_DIM), jnp.float32)
    diff_lambda_q2 = 0.1 * nrm(ks[5], (DEPTH, HEAD_DIM), jnp.float32)
    diff_lambda_k2 = 0.1 * nrm(ks[6], (DEPTH, HEAD_DIM), jnp.float32)
    diff_subln_gain = 1.0 + 0.02 * nrm(ks[7], (DEPTH, 2 * HEAD_DIM), jnp.float32)
    w_out = nrm(ks[8], (DEPTH, MIX_WIDTH, D_MODEL), jnp.float32) * (MIX_WIDTH ** -0.5) * DEEPNORM_BETA
    ln1_gain = 1.0 + 0.02 * nrm(ks[9], (DEPTH, D_MODEL), jnp.float32)
    ln1_bias = 0.02 * nrm(ks[10], (DEPTH, D_MODEL), jnp.float32)
    w_mlp_in = nrm(ks[11], (DEPTH, D_MODEL, D_FF), jnp.float32) * (D_MODEL ** -0.5) * DEEPNORM_BETA
    w_mlp_out = nrm(ks[12], (DEPTH, D_FF, D_MODEL), jnp.float32) * (D_FF ** -0.5) * DEEPNORM_BETA
    ln2_gain = 1.0 + 0.02 * nrm(ks[13], (DEPTH, D_MODEL), jnp.float32)
    ln2_bias = 0.02 * nrm(ks[14], (DEPTH, D_MODEL), jnp.float32)
    return {"x": x, "w_in": w_in, "fox_forget_bias": fox_forget_bias,
            "diff_lambda_q1": diff_lambda_q1, "diff_lambda_k1": diff_lambda_k1,
            "diff_lambda_q2": diff_lambda_q2, "diff_lambda_k2": diff_lambda_k2,
            "diff_subln_gain": diff_subln_gain, "w_out": w_out,
            "ln1_gain": ln1_gain, "ln1_bias": ln1_bias,
            "w_mlp_in": w_mlp_in, "w_mlp_out": w_mlp_out,
            "ln2_gain": ln2_gain, "ln2_bias": ln2_bias}


def reference(x, w_in, fox_forget_bias, diff_lambda_q1, diff_lambda_k1, diff_lambda_q2,
              diff_lambda_k2, diff_subln_gain, w_out, ln1_gain, ln1_bias, w_mlp_in,
              w_mlp_out, ln2_gain, ln2_bias):
    for l in range(DEPTH):
        x = _hybrid_layer(x, l, w_in[l], fox_forget_bias[l], diff_lambda_q1[l], diff_lambda_k1[l],
                          diff_lambda_q2[l], diff_lambda_k2[l], diff_subln_gain[l], w_out[l],
                          ln1_gain[l], ln1_bias[l], w_mlp_in[l], w_mlp_out[l],
                          ln2_gain[l], ln2_bias[l])
    return x
```

```cpp
#include <hip/hip_runtime.h>
#include <hip/hip_cooperative_groups.h>
#include <cstdio>
#include <cstdint>
namespace cg = cooperative_groups;
namespace pg8 {
#define PG8_LAS __attribute__((address_space(3)))
typedef unsigned short bf16_t;
typedef short bf16x8 __attribute__((ext_vector_type(8)));
typedef float f32x4 __attribute__((ext_vector_type(4)));
typedef unsigned u32x4 __attribute__((ext_vector_type(4)));
constexpr int BM = 256, BK = 64, HALF = 128, HTB = HALF * BK * 2  , STAGE_BYTES = 8 * HTB, NXCD = 8, WGM = 8;

__host__ __device__ __forceinline__ int lds_byte(int r, int c) { const int st = (r >> 4) * 2 + (c >> 5), rr = r & 15, cc = c & 31, ob = rr * 64 + cc * 2; return st * 1024 + (ob ^ (((ob >> 9) & 1) << 5)); }
__host__ __device__ __forceinline__ void stage_rc(int b, int& R, int& C) { const int st = b / 1024, sb = b % 1024, swz = sb ^ (((sb >> 9) & 1) << 5); R = (st >> 1) * 16 + swz / 64; C = (st & 1) * 32 + (swz % 64) / 2; }
__host__ __device__ __forceinline__ int perm32(int rho) { const int n = rho >> 4, i = rho & 15; return 8 * (i >> 2) + 4 * n + (i & 3); }

struct Unit { int pm, pn; };
struct Gemm { const bf16_t* A; const bf16_t* Bt; int M, N, K; };

struct StaticOrder {
    int nM, nN, nwg, G, c;
    __host__ __device__ void init(int M, int N, int G_, int c_) { nM = M / BM; nN = N / BM; nwg = nM * nN; G = G_; c = c_; }
    __host__ __device__ bool next(int i, Unit& u) const {
        const long L = (long)i * G + c; if (L >= nwg) return false;
        int wgid = (int)L; { const int q = nwg / NXCD, r = nwg % NXCD, xcd = wgid % NXCD, off = wgid / NXCD; wgid = (xcd < r ? xcd * (q + 1) : r * (q + 1) + (xcd - r) * q) + off; }
        const int nig = WGM * nN, gid = wgid / nig, fm = gid * WGM, gsz = (nM - fm) < WGM ? (nM - fm) : WGM;
        u.pm = fm + ((wgid % nig) % gsz); u.pn = (wgid % nig) / gsz; return true;
    }
    __device__ __forceinline__ void a_ready(const Unit&) const {}
    __device__ __forceinline__ void done(const Unit&) const {}
};

__device__ __forceinline__ unsigned cvt_pk_bf16(float lo, float hi) { unsigned r; asm volatile("v_cvt_pk_bf16_f32 %0, %1, %2" : "=v"(r) : "v"(lo), "v"(hi)); return r; }
typedef float f32x2 __attribute__((ext_vector_type(2)));
__device__ __forceinline__ f32x2 gelu_pk(f32x2 v) {
    const f32x2 av = __builtin_elementwise_abs(v), d = av * 0.2316418882f + 1.0f;
    f32x2 t; t.x = __builtin_amdgcn_rcpf(d.x); t.y = __builtin_amdgcn_rcpf(d.y);
    f32x2 q = t * 0.5307027145f + (-0.7265760135f); q = q * t + 0.7107068705f; q = q * t + (-0.142248368f); q = q * t + 0.127414796f; q = q * t;
    const f32x2 s = (v * v) * (-0.72134752044f);
    f32x2 e; e.x = __builtin_amdgcn_exp2f(s.x); e.y = __builtin_amdgcn_exp2f(s.y);
    const f32x2 m = v * (q * e), r = v - m;
    f32x2 o; o.x = v.x < 0.f ? m.x : r.x; o.y = v.y < 0.f ? m.y : r.y; return o;
}

template <int ACT  > struct EpiBf16 {
    static constexpr bool PERM = true, AFTER_DRAIN = false; static_assert(ACT == 0 || ACT == 1, "EpiBf16: ACT is 0 (none) or 1 (gelu_pk)");
    bf16_t* O; int ldc; const float* bias; int split_cols; size_t split_stride; float scale0;
    __device__ __forceinline__ void operator()(const f32x4 (&acc)[2][2][4][2], const Unit& u, int wr, int wc, int fr, int fq) const {
        const int row0 = u.pm * BM + wr * 64 + fr; int colt = u.pn * BM; bf16_t* base = O;
        float sc = 1.f; if (split_cols) { const int t = colt / split_cols; base += (size_t)t * split_stride; colt -= t * split_cols; if (t == 0) sc = scale0; }
        const int col0 = colt + wc * 32 + 8 * fq, bcol0 = u.pn * BM + wc * 32 + 8 * fq;
        f32x4 bv[2][2];
#pragma unroll
        for (int bj = 0; bj < 2; ++bj)
#pragma unroll
            for (int n = 0; n < 2; ++n) bv[bj][n] = bias ? *(const f32x4*)(bias + bcol0 + bj * HALF + 4 * n) : (f32x4){0.f, 0.f, 0.f, 0.f};
#pragma unroll
        for (int ai = 0; ai < 2; ++ai)
#pragma unroll
            for (int m = 0; m < 4; ++m) { bf16_t* rowp = base + (size_t)(row0 + ai * HALF + m * 16) * ldc + col0;
#pragma unroll
                for (int bj = 0; bj < 2; ++bj) { f32x4 v0 = acc[ai][bj][m][0] + bv[bj][0], v1 = acc[ai][bj][m][1] + bv[bj][1];
                    if (ACT == 1) { f32x2 a = gelu_pk((f32x2){v0[0], v0[1]}), b = gelu_pk((f32x2){v0[2], v0[3]}), c = gelu_pk((f32x2){v1[0], v1[1]}), d = gelu_pk((f32x2){v1[2], v1[3]});
                        v0 = (f32x4){a.x, a.y, b.x, b.y}; v1 = (f32x4){c.x, c.y, d.x, d.y}; }
                    v0 = v0 * sc; v1 = v1 * sc; u32x4 w; w.x = cvt_pk_bf16(v0[0], v0[1]); w.y = cvt_pk_bf16(v0[2], v0[3]); w.z = cvt_pk_bf16(v1[0], v1[1]); w.w = cvt_pk_bf16(v1[2], v1[3]);
                    *(u32x4*)(rowp + bj * HALF) = w; } }
    }
};
template <int ACT  > struct EpiBf16A {
    static constexpr bool PERM = true, AFTER_DRAIN = false;
    bf16_t* O; int ldc;
    __device__ __forceinline__ void operator()(const f32x4 (&acc)[2][2][4][2], const Unit& u, int wr, int wc, int fr, int fq) const {
        const int row0 = u.pm * BM + wr * 64 + fr; const int col0 = u.pn * BM + wc * 32 + 8 * fq;
#pragma unroll
        for (int ai = 0; ai < 2; ++ai)
#pragma unroll
            for (int m = 0; m < 4; ++m) { bf16_t* rowp = O + (size_t)(row0 + ai * HALF + m * 16) * ldc + col0;
#pragma unroll
                for (int bj = 0; bj < 2; ++bj) { f32x4 v0 = acc[ai][bj][m][0], v1 = acc[ai][bj][m][1];
                    if (ACT == 2) { const f32x4 z = {0.f, 0.f, 0.f, 0.f}; v0 = __builtin_elementwise_max(v0, z); v1 = __builtin_elementwise_max(v1, z); v0 = v0 * v0; v1 = v1 * v1; }
                    u32x4 w; w.x = cvt_pk_bf16(v0[0], v0[1]); w.y = cvt_pk_bf16(v0[2], v0[3]); w.z = cvt_pk_bf16(v1[0], v1[1]); w.w = cvt_pk_bf16(v1[2], v1[3]);
                    *(u32x4*)(rowp + bj * HALF) = w; } }
    }
};
struct EpiResF32 {
    static constexpr bool PERM = false, AFTER_DRAIN = false;
    const float* res; float* out; int ldc; float alpha;
    __device__ __forceinline__ void operator()(const f32x4 (&acc)[2][2][4][2], const Unit& u, int wr, int wc, int fr, int fq) const {
        const int col0 = u.pn * BM + wc * 32 + 4 * fq;
#pragma unroll
        for (int ai = 0; ai < 2; ++ai)
#pragma unroll
            for (int m = 0; m < 4; ++m) { const size_t off = (size_t)(u.pm * BM + ai * HALF + wr * 64 + m * 16 + fr) * ldc + col0;
#pragma unroll
                for (int bj = 0; bj < 2; ++bj)
#pragma unroll
                    for (int n = 0; n < 2; ++n) { const f32x4 r = *(const f32x4*)(res + off + bj * HALF + n * 16); const f32x4 o = r * alpha + acc[ai][bj][m][n];
                        *(f32x4*)(out + off + bj * HALF + n * 16) = o; } }
    }
};
template <class Epi, class Sched, bool ALIGN_EPI = false, bool SP2 = false>
__device__ __forceinline__ void gemm_phase(PG8_LAS unsigned char* lds, const Gemm g, const Sched& S, const Epi& E) {
    int tid = threadIdx.x; asm volatile("" : "+v"(tid)); const int wid = __builtin_amdgcn_readfirstlane(tid >> 6), lane = tid & 63, wr = wid >> 2, wc = wid & 3, fr = lane & 15, fq = lane >> 4;
    const int K = g.K, nt = K / BK;
    unsigned voffA[2], voffB[2];
#pragma unroll
    for (int i = 0; i < 2; ++i) { int R, C; stage_rc(tid * 16 + i * 8192, R, C); const int Rb = Epi::PERM ? ((R & ~31) + perm32(R & 31)) : R;
        voffA[i] = (unsigned)(R * K + C) * 2u; voffB[i] = (unsigned)(Rb * K + C) * 2u; }
    const size_t kstep = (size_t)(BK * 2);
    const size_t hstep = (size_t)HALF * K * 2;
    const size_t tstep = 2 * hstep;
    const unsigned ldsw = (unsigned)wid * 1024u;
    const int aoff = lds_byte(wr * 64 + fr, fq * 8), boff = lds_byte(wc * 32 + fr, fq * 8);
#define PG8_SA(b, h) (((b) * 2 + (h)) * HTB)
#define PG8_SB(b, h) ((4 + (b) * 2 + (h)) * HTB)
#define PG8_STAGE(bufoff, gbase, voff) do { _Pragma("unroll") for (int _i = 0; _i < 2; ++_i) \
        __builtin_amdgcn_global_load_lds((const unsigned*)((const char*)(gbase) + (voff)[_i]), (PG8_LAS unsigned*)(lds + (bufoff) + ldsw + _i * 8192), 16, 0, 0); } while (0)
#define PG8_LDA(dst, b, h) do { _Pragma("unroll") for (int m = 0; m < 4; ++m) _Pragma("unroll") for (int k = 0; k < 2; ++k) dst[m][k] = *(const PG8_LAS bf16x8*)(lds + PG8_SA(b, h) + aoff + m * 2048 + k * 1024); } while (0)
#define PG8_LDB(dst, b, h) do { _Pragma("unroll") for (int n = 0; n < 2; ++n) _Pragma("unroll") for (int k = 0; k < 2; ++k) dst[n][k] = *(const PG8_LAS bf16x8*)(lds + PG8_SB(b, h) + boff + n * 2048 + k * 1024); } while (0)
#define PG8_MMA(ai, bj, At, Bt) do { __builtin_amdgcn_s_setprio(1); _Pragma("unroll") for (int m = 0; m < 4; ++m) _Pragma("unroll") for (int n = 0; n < 2; ++n) _Pragma("unroll") for (int k = 0; k < 2; ++k) \
        acc[ai][bj][m][n] = __builtin_amdgcn_mfma_f32_16x16x32_bf16(Bt[n][k], At[m][k], acc[ai][bj][m][n], 0, 0, 0); __builtin_amdgcn_s_setprio(0); } while (0)
#define PG8_WAIT_V(n) asm volatile("s_waitcnt vmcnt(" #n ")" ::: "memory")
#define PG8_WAIT_L(n) asm volatile("s_waitcnt lgkmcnt(" #n ")" ::: "memory")
#define PG8_BAR __builtin_amdgcn_s_barrier()
#define PG8_SCHED __builtin_amdgcn_sched_barrier(0)
    Unit cur, nxt; int ui = 0;
    if (!S.next(0, cur)) return;
    f32x4 acc[2][2][4][2];
#pragma unroll
    for (int a = 0; a < 2; ++a)
#pragma unroll
        for (int b = 0; b < 2; ++b)
#pragma unroll
            for (int m = 0; m < 4; ++m)
#pragma unroll
                for (int n = 0; n < 2; ++n) acc[a][b][m][n] = (f32x4){0.f, 0.f, 0.f, 0.f};
    bf16x8 At[4][2], B0[2][2], B1[2][2];
    const char* cA = (const char*)g.A + (size_t)cur.pm * tstep; const char* cB = (const char*)g.Bt + (size_t)cur.pn * tstep;
    S.a_ready(cur);
    if constexpr (SP2) {
        PG8_STAGE(PG8_SB(0, 0), cB, voffB); PG8_STAGE(PG8_SB(0, 1), cB + hstep, voffB); PG8_STAGE(PG8_SA(0, 0), cA, voffA); PG8_STAGE(PG8_SA(0, 1), cA + hstep, voffA);
        if (wr == 1) PG8_BAR;
        PG8_WAIT_V(2); PG8_BAR;
        PG8_STAGE(PG8_SB(1, 0), cB + kstep, voffB); PG8_STAGE(PG8_SA(1, 0), cA + kstep, voffA); PG8_STAGE(PG8_SB(1, 1), cB + hstep + kstep, voffB);
        PG8_WAIT_V(6); PG8_BAR;
    } else {
        PG8_STAGE(PG8_SB(0, 0), cB, voffB); PG8_STAGE(PG8_SA(0, 0), cA, voffA); PG8_STAGE(PG8_SB(0, 1), cB + hstep, voffB); PG8_STAGE(PG8_SA(0, 1), cA + hstep, voffA);
        if (wr == 1) PG8_BAR;
        PG8_WAIT_V(4); PG8_BAR;
        PG8_STAGE(PG8_SB(1, 0), cB + kstep, voffB); PG8_STAGE(PG8_SA(1, 0), cA + kstep, voffA); PG8_STAGE(PG8_SB(1, 1), cB + hstep + kstep, voffB);
        PG8_WAIT_V(6); PG8_BAR;
    }
    for (;;) {
        const bool has_next = S.next(ui + 1, nxt);
        const char* nA = has_next ? (const char*)g.A + (size_t)nxt.pm * tstep : cA; const char* nB = has_next ? (const char*)g.Bt + (size_t)nxt.pn * tstep : cB;
        for (int t = 0; t < nt; t += 2) {
            const bool last = (t == nt - 2);
            const char* a1 = cA + (size_t)(t + 1) * kstep;
            const char* a2 = last ? nA : cA + (size_t)(t + 2) * kstep; const char* b2 = last ? nB : cB + (size_t)(t + 2) * kstep;
            const char* a3 = a2 + kstep; const char* b3 = b2 + kstep;
            if (last && has_next) S.a_ready(nxt);
            if constexpr (SP2) {
            PG8_LDB(B0, 0, 0); PG8_LDB(B1, 0, 1); PG8_SCHED; PG8_LDA(At, 0, 0); PG8_STAGE(PG8_SA(1, 1), a1 + hstep, voffA);
            PG8_WAIT_V(8); PG8_WAIT_L(0); PG8_BAR; PG8_MMA(0, 0, At, B0); PG8_MMA(0, 1, At, B1); PG8_BAR; PG8_SCHED;
            PG8_LDA(At, 0, 1); PG8_STAGE(PG8_SB(0, 0), b2, voffB); PG8_STAGE(PG8_SB(0, 1), b2 + hstep, voffB); PG8_STAGE(PG8_SA(0, 0), a2, voffA);
            PG8_WAIT_V(8); PG8_WAIT_L(0); PG8_BAR; PG8_MMA(1, 0, At, B0); PG8_MMA(1, 1, At, B1); PG8_BAR; PG8_SCHED;
            PG8_LDB(B0, 1, 0); PG8_LDB(B1, 1, 1); PG8_SCHED; PG8_LDA(At, 1, 0); PG8_STAGE(PG8_SA(0, 1), a2 + hstep, voffA);
            PG8_WAIT_V(8); PG8_WAIT_L(0); PG8_BAR; PG8_MMA(0, 0, At, B0); PG8_MMA(0, 1, At, B1); PG8_BAR; PG8_SCHED;
            PG8_LDA(At, 1, 1); PG8_STAGE(PG8_SB(1, 0), b3, voffB); PG8_STAGE(PG8_SB(1, 1), b3 + hstep, voffB); PG8_STAGE(PG8_SA(1, 0), a3, voffA);
            PG8_WAIT_V(8); PG8_WAIT_L(0); PG8_BAR; PG8_MMA(1, 0, At, B0); PG8_MMA(1, 1, At, B1); PG8_BAR; PG8_SCHED;
            } else {
            PG8_LDB(B0, 0, 0); PG8_SCHED; PG8_LDA(At, 0, 0); PG8_STAGE(PG8_SA(1, 1), a1 + hstep, voffA);
            PG8_WAIT_L(8); PG8_BAR; PG8_WAIT_L(0); PG8_MMA(0, 0, At, B0); PG8_BAR; PG8_SCHED;
            PG8_LDB(B1, 0, 1); PG8_STAGE(PG8_SB(0, 0), b2, voffB);
            PG8_BAR; PG8_WAIT_L(0); PG8_MMA(0, 1, At, B1); PG8_BAR;
            PG8_LDA(At, 0, 1); PG8_STAGE(PG8_SA(0, 0), a2, voffA);
            PG8_BAR; PG8_WAIT_L(0); PG8_MMA(1, 0, At, B0); PG8_BAR; PG8_SCHED;
            PG8_STAGE(PG8_SB(0, 1), b2 + hstep, voffB);
            PG8_WAIT_V(6); PG8_BAR; PG8_MMA(1, 1, At, B1); PG8_BAR;
            PG8_LDB(B0, 1, 0); PG8_SCHED; PG8_LDA(At, 1, 0); PG8_STAGE(PG8_SA(0, 1), a2 + hstep, voffA);
            PG8_WAIT_L(8); PG8_BAR; PG8_WAIT_L(0); PG8_MMA(0, 0, At, B0); PG8_BAR; PG8_SCHED;
            PG8_LDB(B1, 1, 1); PG8_STAGE(PG8_SB(1, 0), b3, voffB);
            PG8_BAR; PG8_WAIT_L(0); PG8_MMA(0, 1, At, B1); PG8_BAR;
            PG8_LDA(At, 1, 1); PG8_STAGE(PG8_SA(1, 0), a3, voffA);
            PG8_BAR; PG8_WAIT_L(0); PG8_MMA(1, 0, At, B0); PG8_BAR; PG8_SCHED;
            PG8_STAGE(PG8_SB(1, 1), b3 + hstep, voffB);
            PG8_WAIT_V(6); PG8_BAR; PG8_MMA(1, 1, At, B1); PG8_BAR;
            }
        }
        if constexpr (ALIGN_EPI) { if (wr == 0) PG8_BAR; }
        if constexpr (!Epi::AFTER_DRAIN) { E(acc, cur, wr, wc, fr, fq); S.done(cur); }
        if (!has_next) break;
#pragma unroll
        for (int a = 0; a < 2; ++a)
#pragma unroll
            for (int b = 0; b < 2; ++b)
#pragma unroll
                for (int m = 0; m < 4; ++m)
#pragma unroll
                    for (int n = 0; n < 2; ++n) acc[a][b][m][n] = (f32x4){0.f, 0.f, 0.f, 0.f};
        cur = nxt; cA = nA; cB = nB; ++ui;
        if constexpr (ALIGN_EPI) { if (wr == 1) PG8_BAR; }
    }
    PG8_WAIT_V(0);
    if constexpr (!ALIGN_EPI) { if (wr == 0) PG8_BAR; }
    PG8_BAR;
    if constexpr (Epi::AFTER_DRAIN) { E.fused(acc, cur, wr, wc, fr, fq, lds, wid, lane); S.done(cur); }
#undef PG8_SA
#undef PG8_SB
#undef PG8_STAGE
#undef PG8_LDA
#undef PG8_LDB
#undef PG8_MMA
#undef PG8_WAIT_V
#undef PG8_WAIT_L
#undef PG8_BAR
#undef PG8_SCHED
}
}

#define LAS __attribute__((address_space(3)))
typedef unsigned short bf16_t;
typedef short bf16x8 __attribute__((ext_vector_type(8)));
typedef float f32x2 __attribute__((ext_vector_type(2)));
typedef float f32x4 __attribute__((ext_vector_type(4)));
typedef float f32x16 __attribute__((ext_vector_type(16)));
typedef unsigned u32x2 __attribute__((ext_vector_type(2)));
typedef unsigned u32x4 __attribute__((ext_vector_type(4)));
typedef __bf16 bf16x2_t __attribute__((ext_vector_type(2)));

constexpr int NB = 4, SEQ = 2048, DM = 2048, MT = NB * SEQ, DFF = 8192, HW = 6144, INW = 6152, NLAYER = 2;
constexpr float LOG2E = 1.4426950408889634f;
constexpr float C2 = 0.125f * LOG2E;
constexpr float DN_ALPHA = 1.4142135623730951f;
constexpr float LN_EPS = 1e-5f, RMS_EPS = 1e-5f;
constexpr int NWAVES = 8, NTHREADS = 512;
constexpr int LDS_BYTES = 147456;

constexpr size_t MiB = 1u << 20;
constexpr size_t WS_CTL = 0, CTL_BYTES = 32768;
constexpr int CW_BAR = 4096;
constexpr size_t WS_WIN = 2 * MiB, WIN_STRIDE = 24 * MiB;
constexpr size_t WS_WOUT = 50 * MiB, WOUT_STRIDE = 8 * MiB;
constexpr size_t WS_W1 = 66 * MiB, W1_STRIDE = 32 * MiB;
constexpr size_t WS_W2 = 130 * MiB, W2_STRIDE = 32 * MiB;
constexpr size_t WS_WFZ = 194 * MiB;
constexpr size_t WS_FZ = 195 * MiB;
constexpr size_t WS_XB = 196 * MiB;
constexpr size_t WS_XF = 228 * MiB;
constexpr size_t WS_H = 292 * MiB;
constexpr size_t WS_VT = 388 * MiB;
constexpr size_t WS_A2 = 292 * MiB;
constexpr size_t WS_MIX = 420 * MiB;
constexpr size_t WS_END = 452 * MiB;

__device__ __forceinline__ unsigned cvtpk(float lo, float hi) { f32x2 v = {lo, hi}; bf16x2_t b = __builtin_convertvector(v, bf16x2_t); return __builtin_bit_cast(unsigned, b); }
__device__ __forceinline__ float xhalf(float v, int hi) {
    auto rr = __builtin_amdgcn_permlane32_swap(__float_as_uint(v), __float_as_uint(v), false, false);
    return __uint_as_float(hi ? rr[0] : rr[1]);
}
__device__ __forceinline__ float wave_sum(float v) {
#pragma unroll
    for (int o = 1; o < 64; o <<= 1) v += __shfl_xor(v, o);
    return v;
}
__device__ __forceinline__ float ex2(float x) { return __builtin_amdgcn_exp2f(x); }
__device__ __forceinline__ float lg2(float x) { return __builtin_amdgcn_logf(x); }
__device__ __forceinline__ float bf2f(unsigned short b) { return __uint_as_float(((unsigned)b) << 16); }

namespace att {
constexpr int PITCH = 144, KT = 64 * PITCH;
constexpr int L_K0 = 0, L_K1 = KT, L_V0 = 2 * KT, L_V1 = 4 * KT, L_CT = 6 * KT, L_FLAG = L_CT + 8192, L_WSUM = L_FLAG + 128, L_END = L_WSUM + 64;
enum { FOX = 0, SB = 1, DIFF = 2, DIL = 3 };
constexpr bool SB_EARLY = true;
constexpr float SB_CUT = -170.f;

template <int MODE, int DV>
__device__ __forceinline__ void attn_pass(f32x16 (&o)[DV / 32], float& l_out, LAS unsigned char* lds, const bf16_t* __restrict__ Hq, const bf16_t* __restrict__ Hk,
                                          const bf16_t* __restrict__ Vtb, int qb, float slope2) {
    int tid = threadIdx.x; asm volatile("" : "+v"(tid)); const int lane = tid & 63, r32 = lane & 31, hi = lane >> 5, wid = __builtin_amdgcn_readfirstlane(tid >> 6);
    const int q0w = 256 * qb + 32 * wid, tq = q0w + r32;
    bf16x8 qf[4];
#pragma unroll
    for (int d0 = 0; d0 < 4; ++d0) qf[d0] = *(const bf16x8*)(Hq + (size_t)tq * HW + 16 * d0 + 8 * hi);
    const f32x16 zero = {0.f, 0.f, 0.f, 0.f, 0.f, 0.f, 0.f, 0.f, 0.f, 0.f, 0.f, 0.f, 0.f, 0.f, 0.f, 0.f};
#pragma unroll
    for (int db = 0; db < DV / 32; ++db) o[db] = zero;
    const int NT = 4 * (qb + 1), my_last = 4 * qb + (wid >> 1);
    const int srow = tid >> 3, sc = tid & 7;
    const bf16_t* kg = Hk + (size_t)srow * HW + 8 * sc;
    const bf16_t* vg = Vtb + (size_t)srow * HW + 8 * sc;
    const int voff = (8 * sc) * PITCH + (((srow & ~12) | ((srow & 4) << 1) | ((srow & 8) >> 1)) * 2);
    const int soff = srow * PITCH + sc * 16;
    constexpr bool DESC = (MODE == SB);
    const LAS float* ctab = (const LAS float*)(lds + L_CT);
    volatile LAS unsigned* flag = (volatile LAS unsigned*)(lds + L_FLAG);
    float ct2 = 0.f;
    if (MODE == FOX) ct2 = ctab[tq];
    float m = -INFINITY, l = 0.f, R = 0.f;
    u32x4 kreg, vreg0, vreg1 = {0u, 0u, 0u, 0u};
#define ATT_GLOAD(t) do { kreg = *(const u32x4*)(kg + (size_t)(t) * 64 * HW); vreg0 = *(const u32x4*)(vg + (size_t)(t) * 64 * HW); if (DV == 128) vreg1 = *(const u32x4*)(vg + 64 + (size_t)(t) * 64 * HW); } while (0)
#define ATT_LWRITE(buf) do { *(LAS u32x4*)(lds + ((buf) ? L_K1 : L_K0) + soff) = kreg; \
        { const bf16x8 v8 = __builtin_bit_cast(bf16x8, vreg0); LAS unsigned char* vd = lds + ((buf) ? L_V1 : L_V0) + voff; \
          _Pragma("unroll") for (int e = 0; e < 8; ++e) *(LAS short*)(vd + e * PITCH) = v8[e]; } \
        if (DV == 128) { const bf16x8 v8 = __builtin_bit_cast(bf16x8, vreg1); LAS unsigned char* vd = lds + ((buf) ? L_V1 : L_V0) + KT + voff; \
          _Pragma("unroll") for (int e = 0; e < 8; ++e) *(LAS short*)(vd + e * PITCH) = v8[e]; } } while (0)
    { const int t0 = DESC ? NT - 1 : 0; ATT_GLOAD(t0); ATT_LWRITE(0); }
    __syncthreads();
    for (int i = 0; i < NT; ++i) {
        const int t = DESC ? NT - 1 - i : i;
        const bool has_next = (i + 1 < NT);
        const int cur = i & 1;
        if (has_next) { const int tn = DESC ? t - 1 : t + 1; ATT_GLOAD(tn); }
        if (t <= my_last) {
            const LAS unsigned char* kb = lds + (cur ? L_K1 : L_K0) + r32 * PITCH + hi * 16;
            const LAS unsigned char* vb = lds + (cur ? L_V1 : L_V0) + r32 * PITCH + hi * 16;
            f32x16 p[2]; p[0] = zero; p[1] = zero;
#pragma unroll
            for (int d0 = 0; d0 < 4; ++d0)
#pragma unroll
                for (int kh = 0; kh < 2; ++kh) { const bf16x8 kf = *(const LAS bf16x8*)(kb + kh * 32 * PITCH + d0 * 32); p[kh] = __builtin_amdgcn_mfma_f32_32x32x16_bf16(kf, qf[d0], p[kh], 0, 0, 0); }
            const int dl = tq - 64 * t - 4 * hi;
            const bool diag = (64 * t + 63 > q0w);
            if (MODE != SB) {
                if (MODE == FOX) {
#pragma unroll
                    for (int kh = 0; kh < 2; ++kh)
#pragma unroll
                        for (int g = 0; g < 4; ++g) { const f32x4 cs = *(const LAS f32x4*)(ctab + 64 * t + 32 * kh + 8 * g + 4 * hi);
#pragma unroll
                            for (int j = 0; j < 4; ++j) p[kh][4 * g + j] = __builtin_fmaf(p[kh][4 * g + j], C2, ct2 - cs[j]); }
                } else {
                    const float b0 = -slope2 * (float)dl;
#pragma unroll
                    for (int kh = 0; kh < 2; ++kh)
#pragma unroll
                        for (int r = 0; r < 16; ++r) { const int cst = 32 * kh + 8 * (r >> 2) + (r & 3);
                            float x = __builtin_fmaf(p[kh][r], C2, __builtin_fmaf(slope2, (float)cst, b0));
                            if (MODE == DIL) { const int d = dl - cst;
                                const float c = ((d <= 128) ? 1.f : 0.f) + ((((d & 3) == 0) && (d <= 512)) ? 1.f : 0.f) + (((d & 15) == 0) ? 1.f : 0.f);
                                x += lg2(c); }
                            p[kh][r] = x; }
                }
                if (diag) {
#pragma unroll
                    for (int kh = 0; kh < 2; ++kh)
#pragma unroll
                        for (int r = 0; r < 16; ++r) { const int cst = 32 * kh + 8 * (r >> 2) + (r & 3); if (cst > dl) p[kh][r] = -INFINITY; }
                }
                float mx = p[0][0];
#pragma unroll
                for (int kh = 0; kh < 2; ++kh)
#pragma unroll
                    for (int r = 0; r < 16; ++r) mx = __builtin_fmaxf(mx, p[kh][r]);
                mx = __builtin_fmaxf(mx, xhalf(mx, hi));
                const float mnew = __builtin_fmaxf(m, mx);
                const float msub = (mnew == -INFINITY) ? 0.f : mnew;
                const float alpha = ex2(m - msub); m = mnew;
                float rs = 0.f;
#pragma unroll
                for (int kh = 0; kh < 2; ++kh)
#pragma unroll
                    for (int r = 0; r < 16; ++r) { const float e = ex2(p[kh][r] - msub); rs += e; p[kh][r] = e; }
                l = l * alpha + rs;
#pragma unroll
                for (int db = 0; db < DV / 32; ++db) o[db] *= alpha;
            } else {
                f32x16 v[2];
#pragma unroll
                for (int kh = 0; kh < 2; ++kh)
#pragma unroll
                    for (int r = 0; r < 16; ++r) { const int cst = 32 * kh + 8 * (r >> 2) + (r & 3);
                        const float y = p[kh][r] * C2; const float e = ex2(-__builtin_fabsf(y)); const float lb = __builtin_fminf(y, 0.f) - lg2(1.f + e);
                        float lom = lb - y; if (diag && !(cst < dl)) lom = 0.f;
                        p[kh][r] = lb; v[kh][r] = lom; }
                float G[2][4], Hh[2][4], T[2][4];
#pragma unroll
                for (int kh = 0; kh < 2; ++kh)
#pragma unroll
                    for (int g = 0; g < 4; ++g) { G[kh][g] = (v[kh][4 * g] + v[kh][4 * g + 1]) + (v[kh][4 * g + 2] + v[kh][4 * g + 3]); Hh[kh][g] = xhalf(G[kh][g], hi); T[kh][g] = G[kh][g] + Hh[kh][g]; }
                float suf = R;
#pragma unroll
                for (int kk = 0; kk < 2; ++kk) { const int kh = 1 - kk;
#pragma unroll
                    for (int gg = 0; gg < 4; ++gg) { const int g = 3 - gg;
                        const float base = suf + (hi == 0 ? Hh[kh][g] : 0.f);
                        const float l3 = base, l2 = l3 + v[kh][4 * g + 3], l1 = l2 + v[kh][4 * g + 2], l0 = l1 + v[kh][4 * g + 1];
                        p[kh][4 * g + 3] = ex2(p[kh][4 * g + 3] + l3); p[kh][4 * g + 2] = ex2(p[kh][4 * g + 2] + l2);
                        p[kh][4 * g + 1] = ex2(p[kh][4 * g + 1] + l1); p[kh][4 * g + 0] = ex2(p[kh][4 * g + 0] + l0);
                        suf += T[kh][g]; } }
                R = suf;
                if (diag) {
#pragma unroll
                    for (int kh = 0; kh < 2; ++kh)
#pragma unroll
                        for (int r = 0; r < 16; ++r) { const int cst = 32 * kh + 8 * (r >> 2) + (r & 3); if (!(cst < dl)) p[kh][r] = 0.f; }
                }
            }
            bf16x8 pf[4];
#pragma unroll
            for (int s = 0; s < 4; ++s) { const int kh = s >> 1, bs = 8 * (s & 1); u32x4 w;
                w.x = cvtpk(p[kh][bs], p[kh][bs + 1]); w.y = cvtpk(p[kh][bs + 2], p[kh][bs + 3]); w.z = cvtpk(p[kh][bs + 4], p[kh][bs + 5]); w.w = cvtpk(p[kh][bs + 6], p[kh][bs + 7]);
                pf[s] = __builtin_bit_cast(bf16x8, w); }
#pragma unroll
            for (int db = 0; db < DV / 32; ++db)
#pragma unroll
                for (int s = 0; s < 4; ++s) { const bf16x8 vf = *(const LAS bf16x8*)(vb + db * 32 * PITCH + s * 32); o[db] = __builtin_amdgcn_mfma_f32_32x32x16_bf16(vf, pf[s], o[db], 0, 0, 0); }
        }
        if (has_next) ATT_LWRITE(cur ^ 1);
        if (MODE == SB && SB_EARLY) { const int done = __all(R < SB_CUT); if (lane == 0) flag[cur * 8 + wid] = done ? 1u : 0u; }
        __syncthreads();
        if (MODE == SB && SB_EARLY) { unsigned all = 1u;
#pragma unroll
            for (int w = 0; w < 8; ++w) all &= flag[cur * 8 + w];
            if (all) break; }
    }
#undef ATT_GLOAD
#undef ATT_LWRITE
    l_out = l + xhalf(l, hi);
}

template <int NDB>
__device__ __forceinline__ void store_o(const f32x16 (&o)[NDB], bf16_t* dst  , int hi) {
#pragma unroll
    for (int db = 0; db < NDB; ++db)
#pragma unroll
        for (int g = 0; g < 4; ++g) { u32x2 w; w.x = cvtpk(o[db][4 * g], o[db][4 * g + 1]); w.y = cvtpk(o[db][4 * g + 2], o[db][4 * g + 3]);
            *(u32x2*)(dst + 32 * db + 8 * g + 4 * hi) = w; }
}

struct Ctx {
    const bf16_t* H; const bf16_t* Vt; bf16_t* MIX; const float* fz; const float* bf; const float* lq1; const float* lk1; const float* lq2; const float* lk2; const float* subg; float lam_init;
};

__device__ __forceinline__ void unit_fox(const Ctx& C, LAS unsigned char* lds, int b, int h, int qb) {
    int tid = threadIdx.x; asm volatile("" : "+v"(tid)); const int lane = tid & 63, r32 = lane & 31, hi = lane >> 5, wid = __builtin_amdgcn_readfirstlane(tid >> 6);
    { LAS float* ctab = (LAS float*)(lds + L_CT); LAS float* wsum = (LAS float*)(lds + L_WSUM);
      const float bfh = C.bf[h]; float v[4];
#pragma unroll
      for (int j = 0; j < 4; ++j) { const float z = (C.fz[(size_t)(b * SEQ + 4 * tid + j) * 8 + h] + bfh) * LOG2E; v[j] = __builtin_fminf(z, 0.f) - lg2(1.f + ex2(-__builtin_fabsf(z))); }
      v[1] += v[0]; v[2] += v[1]; v[3] += v[2];
      float inc = v[3];
#pragma unroll
      for (int o = 1; o < 64; o <<= 1) { const float n = __shfl_up(inc, o); if (lane >= o) inc += n; }
      if (lane == 63) wsum[wid] = inc;
      __syncthreads();
      float off = inc - v[3];
#pragma unroll
      for (int w = 0; w < 8; ++w) if (w < wid) off += wsum[w];
      *(LAS f32x4*)(ctab + 4 * tid) = (f32x4){off + v[0], off + v[1], off + v[2], off + v[3]};
      __syncthreads(); }
    f32x16 o[2]; float l;
    const bf16_t* Hb = C.H + (size_t)b * SEQ * HW;
    attn_pass<FOX, 64>(o, l, lds, Hb + 64 * h, Hb + 512 + 64 * h, Hb + 1024 + 64 * h, qb, 0.f);
    const float inv = 1.0f / l; o[0] *= inv; o[1] *= inv;
    store_o<2>(o, C.MIX + (size_t)(b * SEQ + 256 * qb + 32 * wid + r32) * DM + 64 * h, hi);
}
__device__ __forceinline__ void unit_sb(const Ctx& C, LAS unsigned char* lds, int b, int h, int qb) {
    int tid = threadIdx.x; asm volatile("" : "+v"(tid)); const int lane = tid & 63, r32 = lane & 31, hi = lane >> 5, wid = __builtin_amdgcn_readfirstlane(tid >> 6);
    f32x16 o[2]; float l;
    const bf16_t* Hb = C.H + (size_t)b * SEQ * HW;
    attn_pass<SB, 64>(o, l, lds, Hb + 1536 + 64 * h, Hb + 2048 + 64 * h, Hb + 2560 + 64 * h, qb, 0.f);
    store_o<2>(o, C.MIX + (size_t)(b * SEQ + 256 * qb + 32 * wid + r32) * DM + 512 + 64 * h, hi);
}
__device__ __forceinline__ void unit_dil(const Ctx& C, LAS unsigned char* lds, int b, int h, int qb) {
    int tid = threadIdx.x; asm volatile("" : "+v"(tid)); const int lane = tid & 63, r32 = lane & 31, hi = lane >> 5, wid = __builtin_amdgcn_readfirstlane(tid >> 6);
    f32x16 o[2]; float l;
    const bf16_t* Hb = C.H + (size_t)b * SEQ * HW;
    const float slope2 = exp2f(-8.0f * (float)(h + 5) / 12.0f) * LOG2E;
    attn_pass<DIL, 64>(o, l, lds, Hb + 4608 + 64 * h, Hb + 5120 + 64 * h, Hb + 5632 + 64 * h, qb, slope2);
    const float inv = 1.0f / l; o[0] *= inv; o[1] *= inv;
    store_o<2>(o, C.MIX + (size_t)(b * SEQ + 256 * qb + 32 * wid + r32) * DM + 1536 + 64 * h, hi);
}
__device__ __forceinline__ void unit_diff(const Ctx& C, LAS unsigned char* lds, int b, int h, int qb) {
    int tid = threadIdx.x; asm volatile("" : "+v"(tid)); const int lane = tid & 63, r32 = lane & 31, hi = lane >> 5, wid = __builtin_amdgcn_readfirstlane(tid >> 6);
    const float s1 = wave_sum(C.lq1[lane] * C.lk1[lane]), s2 = wave_sum(C.lq2[lane] * C.lk2[lane]);
    const float lam = expf(s1) - expf(s2) + C.lam_init;
    const bf16_t* Hb = C.H + (size_t)b * SEQ * HW;
    const bf16_t* Vtb = Hb + 4096 + 128 * h;
    const float slope2 = exp2f(-8.0f * (float)(h + 1) / 12.0f) * LOG2E;
    f32x16 o1[4], o2[4]; float l1, l2;
    attn_pass<DIFF, 128>(o1, l1, lds, Hb + 3072 + 128 * h, Hb + 3584 + 128 * h, Vtb, qb, slope2);
    { const float inv = 1.0f / l1;
#pragma unroll
      for (int db = 0; db < 4; ++db) o1[db] *= inv; }
    attn_pass<DIFF, 128>(o2, l2, lds, Hb + 3072 + 128 * h + 64, Hb + 3584 + 128 * h + 64, Vtb, qb, slope2);
    { const float inv = lam / l2; float ss = 0.f;
#pragma unroll
      for (int db = 0; db < 4; ++db) { o1[db] -= o2[db] * inv;
#pragma unroll
          for (int r = 0; r < 16; ++r) ss += o1[db][r] * o1[db][r]; }
      ss += xhalf(ss, hi);
      const float rn = (1.0f / sqrtf(ss * (1.0f / 128.0f) + RMS_EPS)) * (1.0f - C.lam_init);
#pragma unroll
      for (int db = 0; db < 4; ++db)
#pragma unroll
          for (int g = 0; g < 4; ++g) { const f32x4 gg = *(const f32x4*)(C.subg + 32 * db + 8 * g + 4 * hi);
#pragma unroll
              for (int j = 0; j < 4; ++j) o1[db][4 * g + j] *= rn * gg[j]; } }
    store_o<4>(o1, C.MIX + (size_t)(b * SEQ + 256 * qb + 32 * wid + r32) * DM + 1024 + 128 * h, hi);
}

constexpr int NUNITS = 896;
__device__ __forceinline__ void decode_unit(int u, int& mode, int& b, int& h, int& qb) {
    int r = u; bool isd = false; int q = 0;
    if (r < 96) { isd = true; q = 7 - r / 16; r = r % 16; }
    else { r -= 96;
        if (r < 192) { q = 7 - r / 96; r = r % 96; }
        else { r -= 192;
            if (r < 16) { isd = true; q = 1; }
            else { r -= 16;
                if (r < 288) { q = 5 - r / 96; r = r % 96; }
                else { r -= 288;
                    if (r < 16) { isd = true; q = 0; }
                    else { r -= 16; q = 2 - r / 96; r = r % 96; } } } } }
    qb = q;
    if (isd) { mode = DIFF; b = r >> 2; h = r & 3; }
    else { const int k = r >> 5; mode = (k == 0) ? SB : (k == 1) ? DIL : FOX; b = (r & 31) >> 3; h = r & 7; }
}

__device__ __forceinline__ void attn_phase(const Ctx& C, LAS unsigned char* lds, unsigned* ctr) {
    volatile LAS int* su = (volatile LAS int*)(lds + L_END);
    for (;;) {
        if (threadIdx.x == 0) su[0] = (int)atomicAdd(ctr, 1u);
        __syncthreads();
        const int u = su[0];
        __syncthreads();
        if (u >= NUNITS) break;
        int mode, b, h, qb; decode_unit(u, mode, b, h, qb);
#ifndef NO_DIFF
        if (mode == DIFF) unit_diff(C, lds, b, h, qb);
#endif
#ifndef NO_SB
        if (mode == SB) unit_sb(C, lds, b, h, qb);
#endif
#ifndef NO_DIL
        if (mode == DIL) unit_dil(C, lds, b, h, qb);
#endif
#ifndef NO_FOX
        if (mode == FOX) unit_fox(C, lds, b, h, qb);
#endif
    }
}
}

__device__ __forceinline__ void wt_item(const float* __restrict__ W, int Nsrc, int K, bf16_t* __restrict__ WT, int k0, int n0, int csrc, LAS float* scr, int lane) {
    const int lr = lane >> 4, lc = 4 * (lane & 15);
#pragma unroll 8
    for (int i = 0; i < 16; ++i) { const int kk = 4 * i + lr; const f32x4 v = *(const f32x4*)(W + (size_t)(k0 + kk) * Nsrc + csrc + lc);
        scr[kk * 65 + lc] = v[0]; scr[kk * 65 + lc + 1] = v[1]; scr[kk * 65 + lc + 2] = v[2]; scr[kk * 65 + lc + 3] = v[3]; }
    asm volatile("s_waitcnt lgkmcnt(0)" ::: "memory");
    const int c = lane & 7;
#pragma unroll
    for (int i = 0; i < 8; ++i) { const int n = 8 * i + (lane >> 3); const LAS float* s = scr + (8 * c) * 65 + n;
        u32x4 o; o.x = cvtpk(s[0], s[65]); o.y = cvtpk(s[2 * 65], s[3 * 65]); o.z = cvtpk(s[4 * 65], s[5 * 65]); o.w = cvtpk(s[6 * 65], s[7 * 65]);
        *(u32x4*)(WT + (size_t)(n0 + n) * K + k0 + 8 * c) = o; }
    asm volatile("s_waitcnt lgkmcnt(0)" ::: "memory");
}

struct Args { const float* in[15]; float* out; unsigned char* ws; int ph_lo, ph_hi; };

__device__ __forceinline__ void phase_convert(const Args& a, LAS unsigned char* lds) {
    int tid = threadIdx.x; asm volatile("" : "+v"(tid)); const int lane = tid & 63, wid = tid >> 6;
    const int gw = blockIdx.x * NWAVES + wid, NGW = gridDim.x * NWAVES;
    LAS float* scr = (LAS float*)(lds + wid * 16640);
    constexpr int I_IN = 32 * 96, I_OUT = 32 * 32, I_1 = 32 * 128, I_2 = 128 * 32, I_L = I_IN + I_OUT + I_1 + I_2;
    for (int it = gw; it < NLAYER * I_L; it += NGW) {
        const int l = it / I_L; int r = it % I_L;
        if (r < I_IN) { const int kt = r / 96, nt = r % 96, n0 = 64 * nt; wt_item(a.in[1] + (size_t)l * DM * INW, INW, DM, (bf16_t*)(a.ws + WS_WIN + l * WIN_STRIDE), 64 * kt, n0, n0 + (n0 >= 1536 ? 8 : 0), scr, lane); continue; } r -= I_IN;
        if (r < I_OUT) { const int kt = r / 32, nt = r % 32; wt_item(a.in[8] + (size_t)l * DM * DM, DM, DM, (bf16_t*)(a.ws + WS_WOUT + l * WOUT_STRIDE), 64 * kt, 64 * nt, 64 * nt, scr, lane); continue; } r -= I_OUT;
        if (r < I_1) { const int kt = r / 128, nt = r % 128; wt_item(a.in[11] + (size_t)l * DM * DFF, DFF, DM, (bf16_t*)(a.ws + WS_W1 + l * W1_STRIDE), 64 * kt, 64 * nt, 64 * nt, scr, lane); continue; } r -= I_1;
        { const int kt = r / 32, nt = r % 32; wt_item(a.in[12] + (size_t)l * DFF * DM, DM, DFF, (bf16_t*)(a.ws + WS_W2 + l * W2_STRIDE), 64 * kt, 64 * nt, 64 * nt, scr, lane); }
    }
    const int gt = blockIdx.x * NTHREADS + tid, NGT = gridDim.x * NTHREADS;
    const float* x = a.in[0]; bf16_t* XB = (bf16_t*)(a.ws + WS_XB);
    for (int i = gt; i < MT * DM / 8; i += NGT) { const f32x4 v0 = *(const f32x4*)(x + (size_t)i * 8), v1 = *(const f32x4*)(x + (size_t)i * 8 + 4);
        u32x4 o; o.x = cvtpk(v0[0], v0[1]); o.y = cvtpk(v0[2], v0[3]); o.z = cvtpk(v1[0], v1[1]); o.w = cvtpk(v1[2], v1[3]); *(u32x4*)(XB + (size_t)i * 8) = o; }
    float* wfz = (float*)(a.ws + WS_WFZ);
    for (int i = gt; i < NLAYER * 8 * DM; i += NGT) { const int l = i / (8 * DM), h = (i / DM) & 7, k = i % DM; wfz[i] = a.in[1][((size_t)l * DM + k) * INW + 1536 + h]; }
}

__device__ __forceinline__ void phase_fz(const Args& a, int layer) {
    int tid = threadIdx.x; asm volatile("" : "+v"(tid)); const int lane = tid & 63, wid = tid >> 6;
    const int gw = blockIdx.x * NWAVES + wid, NGW = gridDim.x * NWAVES;
    const bf16_t* XB = (const bf16_t*)(a.ws + WS_XB); const float* wfz = (const float*)(a.ws + WS_WFZ) + (size_t)layer * 8 * DM; float* fz = (float*)(a.ws + WS_FZ);
    for (int m = gw; m < MT; m += NGW) {
        float xv[4][8];
#pragma unroll
        for (int j = 0; j < 4; ++j) { const bf16x8 v = *(const bf16x8*)(XB + (size_t)m * DM + 512 * j + 8 * lane);
#pragma unroll
            for (int e = 0; e < 8; ++e) xv[j][e] = bf2f((unsigned short)v[e]); }
        float mine = 0.f;
#pragma unroll
        for (int h = 0; h < 8; ++h) { float acc = 0.f;
#pragma unroll
            for (int j = 0; j < 4; ++j) { const f32x4 w0 = *(const f32x4*)(wfz + h * DM + 512 * j + 8 * lane), w1 = *(const f32x4*)(wfz + h * DM + 512 * j + 8 * lane + 4);
                acc += xv[j][0] * w0[0] + xv[j][1] * w0[1] + xv[j][2] * w0[2] + xv[j][3] * w0[3] + xv[j][4] * w1[0] + xv[j][5] * w1[1] + xv[j][6] * w1[2] + xv[j][7] * w1[3]; }
            acc = wave_sum(acc); if (lane == h) mine = acc; }
        if (lane < 8) fz[(size_t)m * 8 + lane] = mine;
    }
}

__device__ __forceinline__ void phase_vtrans(const Args& a, LAS unsigned char* lds) {
    int tid = threadIdx.x; asm volatile("" : "+v"(tid)); const int lane = tid & 63, wid = tid >> 6;
    const int gw = blockIdx.x * NWAVES + wid, NGW = gridDim.x * NWAVES;
    const bf16_t* H = (const bf16_t*)(a.ws + WS_H); bf16_t* Vt = (bf16_t*)(a.ws + WS_VT);
    LAS unsigned char* scr = lds + wid * 9216;
    for (int it = gw; it < 4 * 32 * 32; it += NGW) {
        const int b = it >> 10, vb = (it >> 5) & 31, tt = it & 31;
        const int vrow0 = 64 * vb, seg = vrow0 >> 9, col0 = 1024 + 1536 * seg + (vrow0 & 511);
        const int c = lane & 7;
#pragma unroll
        for (int i = 0; i < 8; ++i) { const int tok = 8 * i + (lane >> 3); const int tokp = (tok & ~12) | ((tok & 4) << 1) | ((tok & 8) >> 1);
            const bf16x8 v = *(const bf16x8*)(H + (size_t)(b * SEQ + 64 * tt + tok) * HW + col0 + 8 * c);
#pragma unroll
            for (int e = 0; e < 8; ++e) *(LAS short*)(scr + (8 * c + e) * 144 + tokp * 2) = v[e]; }
        asm volatile("s_waitcnt lgkmcnt(0)" ::: "memory");
#pragma unroll
        for (int i = 0; i < 8; ++i) { const int d = 8 * i + (lane >> 3); const u32x4 v = *(const LAS u32x4*)(scr + d * 144 + c * 16);
            *(u32x4*)(Vt + ((size_t)b * 2048 + vrow0 + d) * SEQ + 64 * tt + 8 * c) = v; }
        asm volatile("s_waitcnt lgkmcnt(0)" ::: "memory");
    }
}

__device__ __forceinline__ void phase_ln(const float* src, float* dst, bf16_t* XB, const float* __restrict__ g, const float* __restrict__ bb) {
    int tid = threadIdx.x; asm volatile("" : "+v"(tid)); const int lane = tid & 63, wid = tid >> 6;
    const int gw = blockIdx.x * NWAVES + wid, NGW = gridDim.x * NWAVES;
    for (int m = gw; m < MT; m += NGW) {
        f32x4 v[8]; float s = 0.f;
#pragma unroll
        for (int j = 0; j < 8; ++j) { v[j] = *(const f32x4*)(src + (size_t)m * DM + 4 * (lane + 64 * j)); s += (v[j][0] + v[j][1]) + (v[j][2] + v[j][3]); }
        const float mean = wave_sum(s) * (1.0f / DM); float q = 0.f;
#pragma unroll
        for (int j = 0; j < 8; ++j) { v[j] = v[j] - mean; q += (v[j][0] * v[j][0] + v[j][1] * v[j][1]) + (v[j][2] * v[j][2] + v[j][3] * v[j][3]); }
        const float rstd = 1.0f / sqrtf(wave_sum(q) * (1.0f / DM) + LN_EPS);
#pragma unroll
        for (int j = 0; j < 8; ++j) { const int cidx = 4 * (lane + 64 * j); const f32x4 gg = *(const f32x4*)(g + cidx), b4 = *(const f32x4*)(bb + cidx);
            const f32x4 y = v[j] * rstd * gg + b4;
            *(f32x4*)(dst + (size_t)m * DM + cidx) = y;
            u32x2 w; w.x = cvtpk(y[0], y[1]); w.y = cvtpk(y[2], y[3]); *(u32x2*)(XB + (size_t)m * DM + cidx) = w; }
    }
}

#define XB_TMO      128
#define XB_XCNT(j)  (256  + 64 * (j))
#define XB_XSUB(j)  (1280 + 64 * (j))
#define XB_XGEN(j)  (2304 + 64 * (j))
#define XB_TOP      3328
#define XB_TOPGEN   3392
#define XCD_BAR_WORDS 3456
#define XB_SPIN_CAP (1u << 18)

__device__ __forceinline__ unsigned xb_ld(unsigned* p)              { return __hip_atomic_load(p, __ATOMIC_RELAXED, __HIP_MEMORY_SCOPE_AGENT); }
__device__ __forceinline__ unsigned xb_add(unsigned* p, unsigned v) { return __hip_atomic_fetch_add(p, v, __ATOMIC_RELAXED, __HIP_MEMORY_SCOPE_AGENT); }
__device__ __forceinline__ unsigned xb_xcc_id() { return (unsigned)__builtin_amdgcn_s_getreg((3 << 11) | 20) & 0xFu; }
#define XB_SPIN(cond, bar) do { unsigned _sp = 0; while (cond) { __builtin_amdgcn_s_sleep(1); \
    if ((++_sp & 255u) == 0u) { if (xb_ld(&(bar)[XB_TMO])) break; if (_sp > XB_SPIN_CAP) { atomicAdd(&(bar)[XB_TMO], 1u); break; } } } } while (0)

struct XcdBarrier {
    unsigned* bar; unsigned x;
    volatile LAS unsigned* st;
};

__device__ __forceinline__ XcdBarrier xcd_barrier_post(unsigned* bar, volatile LAS unsigned* st) {
    XcdBarrier b; b.bar = bar; b.x = xb_xcc_id(); b.st = st;
    if (threadIdx.x == 0) (void)xb_add(&bar[XB_XCNT(b.x)], 1u);
    return b;
}
__device__ __forceinline__ void xcd_barrier_complete(unsigned* bar, unsigned x, unsigned& nloc, unsigned& nx) {
    const unsigned G = gridDim.x * gridDim.y * gridDim.z;
    unsigned sum, cnt, mine, sp = 0u;
    for (;;) {
        sum = 0u; cnt = 0u; mine = 0u;
#pragma unroll
        for (unsigned j = 0; j < 16; ++j) { const unsigned c = xb_ld(&bar[XB_XCNT(j)]); sum += c; cnt += (c > 0u) ? 1u : 0u; mine = (j == x) ? c : mine; }
        if (sum == G) break;
        __builtin_amdgcn_s_sleep(1);
        if ((++sp & 255u) == 0u) { if (xb_ld(&bar[XB_TMO])) break; if (sp > XB_SPIN_CAP) { atomicAdd(&bar[XB_TMO], 1u); break; } }
    }
    nloc = mine > 0u ? mine : 1u; nx = cnt > 0u ? cnt : 1u;
}

__device__ __forceinline__ void xcd_barrier(const XcdBarrier& b) {
    asm volatile("s_waitcnt vmcnt(0)" ::: "memory");
    __syncthreads();
    if (threadIdx.x == 0) {
        unsigned* bar = b.bar;
        __builtin_amdgcn_s_waitcnt(0);
        unsigned nloc = b.st[0], nx = b.st[1];
        if (nloc == 0u) { xcd_barrier_complete(bar, b.x, nloc, nx); b.st[0] = nloc; b.st[1] = nx; }
        const unsigned old = xb_add(&bar[XB_XSUB(b.x)], 1u);
        const unsigned gen = old / nloc;
        if (old + 1u == (gen + 1u) * nloc) {
            __builtin_amdgcn_fence(__ATOMIC_RELEASE, "agent");
            asm volatile("s_waitcnt vmcnt(0)" ::: "memory");
            const unsigned og = xb_add(&bar[XB_TOP], 1u);
            const unsigned tg = og / nx;
            if (og + 1u == (tg + 1u) * nx) xb_add(&bar[XB_TOPGEN], 1u);
            else XB_SPIN(xb_ld(&bar[XB_TOPGEN]) == tg, bar);
            __builtin_amdgcn_fence(__ATOMIC_ACQUIRE, "agent");
            xb_add(&bar[XB_XGEN(b.x)], 1u);
            asm volatile("s_waitcnt vmcnt(0)" ::: "memory");
        } else {
            XB_SPIN(xb_ld(&bar[XB_XGEN(b.x)]) == gen, bar);
            __builtin_amdgcn_fence(__ATOMIC_ACQUIRE, "agent");
            asm volatile("s_waitcnt vmcnt(0)" ::: "memory");
        }
    }
    __syncthreads();
}

#ifndef PHM
#define PHM 511
#endif
#ifndef GSYNC_PH
#define GSYNC_PH 0
#endif
constexpr int PH_PER_LAYER = 7, N_PHASES = 1 + NLAYER * PH_PER_LAYER;

__global__ void __launch_bounds__(NTHREADS, 2) fwd_megakernel(Args a) {
    extern __shared__ __attribute__((aligned(16))) unsigned char lds_raw[];
    LAS unsigned char* lds = (LAS unsigned char*)lds_raw;
    cg::grid_group grid = cg::this_grid();
    unsigned char* ws = a.ws;
    volatile LAS unsigned* bst = (volatile LAS unsigned*)(lds + LDS_BYTES - 64);
    if (threadIdx.x < 16) bst[threadIdx.x] = 0u;
    __syncthreads();
    XcdBarrier xbar = xcd_barrier_post((unsigned*)(ws + WS_CTL) + CW_BAR, bst);
    bf16_t* XB = (bf16_t*)(ws + WS_XB); float* XF = (float*)(ws + WS_XF); bf16_t* Hb = (bf16_t*)(ws + WS_H); bf16_t* MIX = (bf16_t*)(ws + WS_MIX); bf16_t* A2 = (bf16_t*)(ws + WS_A2);
    for (int ph = a.ph_lo; ph < a.ph_hi; ++ph) {
        if (ph == 0) { if (PHM & 1) phase_convert(a, lds);
#ifdef PROBE_CV2
            phase_convert(a, lds);
#endif
        }
        else {
            const int layer = (ph - 1) / PH_PER_LAYER, sub = (ph - 1) % PH_PER_LAYER;
            if (sub == 0 && (PHM & 2)) {
                pg8::Gemm g{XB, (const bf16_t*)(ws + WS_WIN + layer * WIN_STRIDE), MT, HW, DM}; pg8::StaticOrder S; S.init(MT, HW, (int)gridDim.x, (int)blockIdx.x);
                pg8::EpiBf16A<0> E{Hb, HW};
                pg8::gemm_phase<pg8::EpiBf16A<0>, pg8::StaticOrder, true, true>(lds, g, S, E);
#ifdef PROBE_G1
                pg8::gemm_phase<pg8::EpiBf16A<0>, pg8::StaticOrder, true, true>(lds, g, S, E);
#endif
                phase_fz(a, layer);
            } else if (sub == 1 && (PHM & 8)) {
                att::Ctx C; C.H = Hb; C.Vt = (const bf16_t*)(ws + WS_VT); C.MIX = MIX; C.fz = (const float*)(ws + WS_FZ); C.bf = a.in[2] + layer * 8;
                C.lq1 = a.in[3] + layer * 64; C.lk1 = a.in[4] + layer * 64; C.lq2 = a.in[5] + layer * 64; C.lk2 = a.in[6] + layer * 64; C.subg = a.in[7] + layer * 128;
                C.lam_init = 0.8f - 0.6f * expf(-0.3f * (float)layer);
                att::attn_phase(C, lds, (unsigned*)(ws + WS_CTL) + 64 * (1 + layer));
#ifdef PROBE_ATT2
                att::attn_phase(C, lds, (unsigned*)(ws + WS_CTL) + 64 * (5 + layer));
#endif
            } else if (sub == 2 && (PHM & 16)) {
                pg8::Gemm g{MIX, (const bf16_t*)(ws + WS_WOUT + layer * WOUT_STRIDE), MT, DM, DM}; pg8::StaticOrder S; S.init(MT, DM, (int)gridDim.x, (int)blockIdx.x);
                pg8::EpiResF32 E{layer == 0 ? a.in[0] : (const float*)XF, XF, DM, DN_ALPHA};
                pg8::gemm_phase<pg8::EpiResF32, pg8::StaticOrder, true, true>(lds, g, S, E);
            } else if (sub == 3 && (PHM & 32)) { phase_ln(XF, XF, XB, a.in[9] + layer * DM, a.in[10] + layer * DM);
            } else if (sub == 4 && (PHM & 64)) {
                pg8::Gemm g{XB, (const bf16_t*)(ws + WS_W1 + layer * W1_STRIDE), MT, DFF, DM}; pg8::StaticOrder S; S.init(MT, DFF, (int)gridDim.x, (int)blockIdx.x);
                pg8::EpiBf16A<2> E{A2, DFF};
                pg8::gemm_phase<pg8::EpiBf16A<2>, pg8::StaticOrder, true, true>(lds, g, S, E);
#ifdef PROBE_G3
                pg8::gemm_phase<pg8::EpiBf16A<2>, pg8::StaticOrder, true, true>(lds, g, S, E);
#endif
            } else if (sub == 5 && (PHM & 128)) {
                pg8::Gemm g{A2, (const bf16_t*)(ws + WS_W2 + layer * W2_STRIDE), MT, DM, DFF}; pg8::StaticOrder S; S.init(MT, DM, (int)gridDim.x, (int)blockIdx.x);
                pg8::EpiResF32 E{XF, XF, DM, DN_ALPHA};
                pg8::gemm_phase<pg8::EpiResF32, pg8::StaticOrder, true, true>(lds, g, S, E);
            } else if (sub == 6 && (PHM & 256)) { phase_ln(XF, layer == NLAYER - 1 ? a.out : XF, XB, a.in[13] + layer * DM, a.in[14] + layer * DM); }
        }
        if (ph + 1 < a.ph_hi) { if (ph == GSYNC_PH) grid.sync(); else xcd_barrier(xbar); }
    }
}

#ifndef MK_PER_PHASE
#define MK_PER_PHASE 0
#endif
extern "C" void kernel_launch(void* const* d_in, const int* in_sizes, int n_in, void* d_out, int out_size, void* d_ws, size_t ws_size, hipStream_t stream) {
    static int grid = 0;
    if (grid == 0) {
        if (n_in != 15 || in_sizes[0] != MT * DM || out_size != MT * DM || ws_size < WS_END) { fprintf(stderr, "kernel_launch: unexpected shapes / workspace (n_in %d, ws %zu)\n", n_in, ws_size); grid = -1; return; }
        int dev = 0, cus = 0, per_cu = 0;
        (void)hipGetDevice(&dev); (void)hipDeviceGetAttribute(&cus, hipDeviceAttributeMultiprocessorCount, dev);
        if (hipFuncSetAttribute((const void*)fwd_megakernel, hipFuncAttributeMaxDynamicSharedMemorySize, LDS_BYTES) != hipSuccess) { fprintf(stderr, "kernel_launch: hipFuncSetAttribute failed\n"); grid = -1; return; }
        if (hipOccupancyMaxActiveBlocksPerMultiprocessor(&per_cu, (const void*)fwd_megakernel, NTHREADS, LDS_BYTES) != hipSuccess || per_cu < 1) { fprintf(stderr, "kernel_launch: occupancy query says %d blocks per CU\n", per_cu); grid = -1; (void)hipGetLastError(); return; }
        grid = cus;
    }
    if (grid < 0) return;
    (void)hipMemsetAsync((char*)d_ws + WS_CTL, 0, CTL_BYTES, stream);
    Args a{};
    for (int i = 0; i < 15; ++i) a.in[i] = (const float*)d_in[i];
    a.out = (float*)d_out; a.ws = (unsigned char*)d_ws;
#if MK_PER_PHASE
    for (int ph = 0; ph < N_PHASES; ++ph) { a.ph_lo = ph; a.ph_hi = ph + 1; hipLaunchKernelGGL(fwd_megakernel, dim3(grid), dim3(NTHREADS), LDS_BYTES, stream, a); }
#else
    a.ph_lo = 0; a.ph_hi = N_PHASES;
    void* args[] = {&a};
    hipError_t e = hipLaunchCooperativeKernel((void*)fwd_megakernel, dim3(grid), dim3(NTHREADS), args, LDS_BYTES, stream);
    if (e != hipSuccess) fprintf(stderr, "cooperative launch failed: %s (grid %d)\n", hipGetErrorString(e), grid);
#endif
}
```

```cpp
#include <hip/hip_runtime.h>
#include <hip/hip_cooperative_groups.h>
#include <cstdio>
#include <cstdint>
namespace cg = cooperative_groups;
namespace pg8 {
#define PG8_LAS __attribute__((address_space(3)))
typedef unsigned short bf16_t;
typedef short bf16x8 __attribute__((ext_vector_type(8)));
typedef float f32x4 __attribute__((ext_vector_type(4)));
typedef unsigned u32x4 __attribute__((ext_vector_type(4)));
constexpr int BM = 256, BK = 64, HALF = 128, HTB = HALF * BK * 2  , STAGE_BYTES = 8 * HTB, NXCD = 8, WGM = 8;

__host__ __device__ __forceinline__ int lds_byte(int r, int c) { const int st = (r >> 4) * 2 + (c >> 5), rr = r & 15, cc = c & 31, ob = rr * 64 + cc * 2; return st * 1024 + (ob ^ (((ob >> 9) & 1) << 5)); }
__host__ __device__ __forceinline__ void stage_rc(int b, int& R, int& C) { const int st = b / 1024, sb = b % 1024, swz = sb ^ (((sb >> 9) & 1) << 5); R = (st >> 1) * 16 + swz / 64; C = (st & 1) * 32 + (swz % 64) / 2; }
__host__ __device__ __forceinline__ int perm32(int rho) { const int n = rho >> 4, i = rho & 15; return 8 * (i >> 2) + 4 * n + (i & 3); }

struct Unit { int pm, pn; };
struct Gemm { const bf16_t* A; const bf16_t* Bt; int M, N, K; };

struct StaticOrder {
    int nM, nN, nwg, G, c;
    __host__ __device__ void init(int M, int N, int G_, int c_) { nM = M / BM; nN = N / BM; nwg = nM * nN; G = G_; c = c_; }
    __host__ __device__ bool next(int i, Unit& u) const {
        const long L = (long)i * G + c; if (L >= nwg) return false;
        int wgid = (int)L; { const int q = nwg / NXCD, r = nwg % NXCD, xcd = wgid % NXCD, off = wgid / NXCD; wgid = (xcd < r ? xcd * (q + 1) : r * (q + 1) + (xcd - r) * q) + off; }
        const int nig = WGM * nN, gid = wgid / nig, fm = gid * WGM, gsz = (nM - fm) < WGM ? (nM - fm) : WGM;
        u.pm = fm + ((wgid % nig) % gsz); u.pn = (wgid % nig) / gsz; return true;
    }
    __device__ __forceinline__ void a_ready(const Unit&) const {}
    __device__ __forceinline__ void done(const Unit&) const {}
};

__device__ __forceinline__ unsigned cvt_pk_bf16(float lo, float hi) { unsigned r; asm volatile("v_cvt_pk_bf16_f32 %0, %1, %2" : "=v"(r) : "v"(lo), "v"(hi)); return r; }
typedef float f32x2 __attribute__((ext_vector_type(2)));
__device__ __forceinline__ f32x2 gelu_pk(f32x2 v) {
    const f32x2 av = __builtin_elementwise_abs(v), d = av * 0.2316418882f + 1.0f;
    f32x2 t; t.x = __builtin_amdgcn_rcpf(d.x); t.y = __builtin_amdgcn_rcpf(d.y);
    f32x2 q = t * 0.5307027145f + (-0.7265760135f); q = q * t + 0.7107068705f; q = q * t + (-0.142248368f); q = q * t + 0.127414796f; q = q * t;
    const f32x2 s = (v * v) * (-0.72134752044f);
    f32x2 e; e.x = __builtin_amdgcn_exp2f(s.x); e.y = __builtin_amdgcn_exp2f(s.y);
    const f32x2 m = v * (q * e), r = v - m;
    f32x2 o; o.x = v.x < 0.f ? m.x : r.x; o.y = v.y < 0.f ? m.y : r.y; return o;
}

template <int ACT  > struct EpiBf16 {
    static constexpr bool PERM = true, AFTER_DRAIN = false; static_assert(ACT == 0 || ACT == 1, "EpiBf16: ACT is 0 (none) or 1 (gelu_pk)");
    bf16_t* O; int ldc; const float* bias; int split_cols; size_t split_stride; float scale0;
    __device__ __forceinline__ void operator()(const f32x4 (&acc)[2][2][4][2], const Unit& u, int wr, int wc, int fr, int fq) const {
        const int row0 = u.pm * BM + wr * 64 + fr; int colt = u.pn * BM; bf16_t* base = O;
        float sc = 1.f; if (split_cols) { const int t = colt / split_cols; base += (size_t)t * split_stride; colt -= t * split_cols; if (t == 0) sc = scale0; }
        const int col0 = colt + wc * 32 + 8 * fq, bcol0 = u.pn * BM + wc * 32 + 8 * fq;
        f32x4 bv[2][2];
#pragma unroll
        for (int bj = 0; bj < 2; ++bj)
#pragma unroll
            for (int n = 0; n < 2; ++n) bv[bj][n] = bias ? *(const f32x4*)(bias + bcol0 + bj * HALF + 4 * n) : (f32x4){0.f, 0.f, 0.f, 0.f};
#pragma unroll
        for (int ai = 0; ai < 2; ++ai)
#pragma unroll
            for (int m = 0; m < 4; ++m) { bf16_t* rowp = base + (size_t)(row0 + ai * HALF + m * 16) * ldc + col0;
#pragma unroll
                for (int bj = 0; bj < 2; ++bj) { f32x4 v0 = acc[ai][bj][m][0] + bv[bj][0], v1 = acc[ai][bj][m][1] + bv[bj][1];
                    if (ACT == 1) { f32x2 a = gelu_pk((f32x2){v0[0], v0[1]}), b = gelu_pk((f32x2){v0[2], v0[3]}), c = gelu_pk((f32x2){v1[0], v1[1]}), d = gelu_pk((f32x2){v1[2], v1[3]});
                        v0 = (f32x4){a.x, a.y, b.x, b.y}; v1 = (f32x4){c.x, c.y, d.x, d.y}; }
                    v0 = v0 * sc; v1 = v1 * sc; u32x4 w; w.x = cvt_pk_bf16(v0[0], v0[1]); w.y = cvt_pk_bf16(v0[2], v0[3]); w.z = cvt_pk_bf16(v1[0], v1[1]); w.w = cvt_pk_bf16(v1[2], v1[3]);
                    *(u32x4*)(rowp + bj * HALF) = w; } }
    }
};
template <int ACT  > struct EpiBf16A {
    static constexpr bool PERM = true, AFTER_DRAIN = false;
    bf16_t* O; int ldc;
    __device__ __forceinline__ void operator()(const f32x4 (&acc)[2][2][4][2], const Unit& u, int wr, int wc, int fr, int fq) const {
        const int row0 = u.pm * BM + wr * 64 + fr; const int col0 = u.pn * BM + wc * 32 + 8 * fq;
#pragma unroll
        for (int ai = 0; ai < 2; ++ai)
#pragma unroll
            for (int m = 0; m < 4; ++m) { bf16_t* rowp = O + (size_t)(row0 + ai * HALF + m * 16) * ldc + col0;
#pragma unroll
                for (int bj = 0; bj < 2; ++bj) { f32x4 v0 = acc[ai][bj][m][0], v1 = acc[ai][bj][m][1];
                    if (ACT == 2) { const f32x4 z = {0.f, 0.f, 0.f, 0.f}; v0 = __builtin_elementwise_max(v0, z); v1 = __builtin_elementwise_max(v1, z); v0 = v0 * v0; v1 = v1 * v1; }
                    u32x4 w; w.x = cvt_pk_bf16(v0[0], v0[1]); w.y = cvt_pk_bf16(v0[2], v0[3]); w.z = cvt_pk_bf16(v1[0], v1[1]); w.w = cvt_pk_bf16(v1[2], v1[3]);
                    *(u32x4*)(rowp + bj * HALF) = w; } }
    }
};
struct EpiResF32 {
    static constexpr bool PERM = false, AFTER_DRAIN = false;
    const float* res; float* out; int ldc; float alpha;
    __device__ __forceinline__ void operator()(const f32x4 (&acc)[2][2][4][2], const Unit& u, int wr, int wc, int fr, int fq) const {
        const int col0 = u.pn * BM + wc * 32 + 4 * fq;
#pragma unroll
        for (int ai = 0; ai < 2; ++ai)
#pragma unroll
            for (int m = 0; m < 4; ++m) { const size_t off = (size_t)(u.pm * BM + ai * HALF + wr * 64 + m * 16 + fr) * ldc + col0;
#pragma unroll
                for (int bj = 0; bj < 2; ++bj)
#pragma unroll
                    for (int n = 0; n < 2; ++n) { const f32x4 r = *(const f32x4*)(res + off + bj * HALF + n * 16); const f32x4 o = r * alpha + acc[ai][bj][m][n];
                        *(f32x4*)(out + off + bj * HALF + n * 16) = o; } }
    }
};
template <class Epi, class Sched, bool ALIGN_EPI = false, bool SP2 = false>
__device__ __forceinline__ void gemm_phase(PG8_LAS unsigned char* lds, const Gemm g, const Sched& S, const Epi& E) {
    int tid = threadIdx.x; asm volatile("" : "+v"(tid)); const int wid = __builtin_amdgcn_readfirstlane(tid >> 6), lane = tid & 63, wr = wid >> 2, wc = wid & 3, fr = lane & 15, fq = lane >> 4;
    const int K = g.K, nt = K / BK;
    unsigned voffA[2], voffB[2];
#pragma unroll
    for (int i = 0; i < 2; ++i) { int R, C; stage_rc(tid * 16 + i * 8192, R, C); const int Rb = Epi::PERM ? ((R & ~31) + perm32(R & 31)) : R;
        voffA[i] = (unsigned)(R * K + C) * 2u; voffB[i] = (unsigned)(Rb * K + C) * 2u; }
    const size_t kstep = (size_t)(BK * 2);
    const size_t hstep = (size_t)HALF * K * 2;
    const size_t tstep = 2 * hstep;
    const unsigned ldsw = (unsigned)wid * 1024u;
    const int aoff = lds_byte(wr * 64 + fr, fq * 8), boff = lds_byte(wc * 32 + fr, fq * 8);
#define PG8_SA(b, h) (((b) * 2 + (h)) * HTB)
#define PG8_SB(b, h) ((4 + (b) * 2 + (h)) * HTB)
#define PG8_STAGE(bufoff, gbase, voff) do { _Pragma("unroll") for (int _i = 0; _i < 2; ++_i) \
        __builtin_amdgcn_global_load_lds((const unsigned*)((const char*)(gbase) + (voff)[_i]), (PG8_LAS unsigned*)(lds + (bufoff) + ldsw + _i * 8192), 16, 0, 0); } while (0)
#define PG8_LDA(dst, b, h) do { _Pragma("unroll") for (int m = 0; m < 4; ++m) _Pragma("unroll") for (int k = 0; k < 2; ++k) dst[m][k] = *(const PG8_LAS bf16x8*)(lds + PG8_SA(b, h) + aoff + m * 2048 + k * 1024); } while (0)
#define PG8_LDB(dst, b, h) do { _Pragma("unroll") for (int n = 0; n < 2; ++n) _Pragma("unroll") for (int k = 0; k < 2; ++k) dst[n][k] = *(const PG8_LAS bf16x8*)(lds + PG8_SB(b, h) + boff + n * 2048 + k * 1024); } while (0)
#define PG8_MMA(ai, bj, At, Bt) do { __builtin_amdgcn_s_setprio(1); _Pragma("unroll") for (int m = 0; m < 4; ++m) _Pragma("unroll") for (int n = 0; n < 2; ++n) _Pragma("unroll") for (int k = 0; k < 2; ++k) \
        acc[ai][bj][m][n] = __builtin_amdgcn_mfma_f32_16x16x32_bf16(Bt[n][k], At[m][k], acc[ai][bj][m][n], 0, 0, 0); __builtin_amdgcn_s_setprio(0); } while (0)
#define PG8_WAIT_V(n) asm volatile("s_waitcnt vmcnt(" #n ")" ::: "memory")
#define PG8_WAIT_L(n) asm volatile("s_waitcnt lgkmcnt(" #n ")" ::: "memory")
#define PG8_BAR __builtin_amdgcn_s_barrier()
#define PG8_SCHED __builtin_amdgcn_sched_barrier(0)
    Unit cur, nxt; int ui = 0;
    if (!S.next(0, cur)) return;
    f32x4 acc[2][2][4][2];
#pragma unroll
    for (int a = 0; a < 2; ++a)
#pragma unroll
        for (int b = 0; b < 2; ++b)
#pragma unroll
            for (int m = 0; m < 4; ++m)
#pragma unroll
                for (int n = 0; n < 2; ++n) acc[a][b][m][n] = (f32x4){0.f, 0.f, 0.f, 0.f};
    bf16x8 At[4][2], B0[2][2], B1[2][2];
    const char* cA = (const char*)g.A + (size_t)cur.pm * tstep; const char* cB = (const char*)g.Bt + (size_t)cur.pn * tstep;
    S.a_ready(cur);
    if constexpr (SP2) {
        PG8_STAGE(PG8_SB(0, 0), cB, voffB); PG8_STAGE(PG8_SB(0, 1), cB + hstep, voffB); PG8_STAGE(PG8_SA(0, 0), cA, voffA); PG8_STAGE(PG8_SA(0, 1), cA + hstep, voffA);
        if (wr == 1) PG8_BAR;
        PG8_WAIT_V(2); PG8_BAR;
        PG8_STAGE(PG8_SB(1, 0), cB + kstep, voffB); PG8_STAGE(PG8_SA(1, 0), cA + kstep, voffA); PG8_STAGE(PG8_SB(1, 1), cB + hstep + kstep, voffB);
        PG8_WAIT_V(6); PG8_BAR;
    } else {
        PG8_STAGE(PG8_SB(0, 0), cB, voffB); PG8_STAGE(PG8_SA(0, 0), cA, voffA); PG8_STAGE(PG8_SB(0, 1), cB + hstep, voffB); PG8_STAGE(PG8_SA(0, 1), cA + hstep, voffA);
        if (wr == 1) PG8_BAR;
        PG8_WAIT_V(4); PG8_BAR;
        PG8_STAGE(PG8_SB(1, 0), cB + kstep, voffB); PG8_STAGE(PG8_SA(1, 0), cA + kstep, voffA); PG8_STAGE(PG8_SB(1, 1), cB + hstep + kstep, voffB);
        PG8_WAIT_V(6); PG8_BAR;
    }
    for (;;) {
        const bool has_next = S.next(ui + 1, nxt);
        const char* nA = has_next ? (const char*)g.A + (size_t)nxt.pm * tstep : cA; const char* nB = has_next ? (const char*)g.Bt + (size_t)nxt.pn * tstep : cB;
        for (int t = 0; t < nt; t += 2) {
            const bool last = (t == nt - 2);
            const char* a1 = cA + (size_t)(t + 1) * kstep;
            const char* a2 = last ? nA : cA + (size_t)(t + 2) * kstep; const char* b2 = last ? nB : cB + (size_t)(t + 2) * kstep;
            const char* a3 = a2 + kstep; const char* b3 = b2 + kstep;
            if (last && has_next) S.a_ready(nxt);
            if constexpr (SP2) {
            PG8_LDB(B0, 0, 0); PG8_LDB(B1, 0, 1); PG8_SCHED; PG8_LDA(At, 0, 0); PG8_STAGE(PG8_SA(1, 1), a1 + hstep, voffA);
            PG8_WAIT_V(8); PG8_WAIT_L(0); PG8_BAR; PG8_MMA(0, 0, At, B0); PG8_MMA(0, 1, At, B1); PG8_BAR; PG8_SCHED;
            PG8_LDA(At, 0, 1); PG8_STAGE(PG8_SB(0, 0), b2, voffB); PG8_STAGE(PG8_SB(0, 1), b2 + hstep, voffB); PG8_STAGE(PG8_SA(0, 0), a2, voffA);
            PG8_WAIT_V(8); PG8_WAIT_L(0); PG8_BAR; PG8_MMA(1, 0, At, B0); PG8_MMA(1, 1, At, B1); PG8_BAR; PG8_SCHED;
            PG8_LDB(B0, 1, 0); PG8_LDB(B1, 1, 1); PG8_SCHED; PG8_LDA(At, 1, 0); PG8_STAGE(PG8_SA(0, 1), a2 + hstep, voffA);
            PG8_WAIT_V(8); PG8_WAIT_L(0); PG8_BAR; PG8_MMA(0, 0, At, B0); PG8_MMA(0, 1, At, B1); PG8_BAR; PG8_SCHED;
            PG8_LDA(At, 1, 1); PG8_STAGE(PG8_SB(1, 0), b3, voffB); PG8_STAGE(PG8_SB(1, 1), b3 + hstep, voffB); PG8_STAGE(PG8_SA(1, 0), a3, voffA);
            PG8_WAIT_V(8); PG8_WAIT_L(0); PG8_BAR; PG8_MMA(1, 0, At, B0); PG8_MMA(1, 1, At, B1); PG8_BAR; PG8_SCHED;
            } else {
            PG8_LDB(B0, 0, 0); PG8_SCHED; PG8_LDA(At, 0, 0); PG8_STAGE(PG8_SA(1, 1), a1 + hstep, voffA);
            PG8_WAIT_L(8); PG8_BAR; PG8_WAIT_L(0); PG8_MMA(0, 0, At, B0); PG8_BAR; PG8_SCHED;
            PG8_LDB(B1, 0, 1); PG8_STAGE(PG8_SB(0, 0), b2, voffB);
            PG8_BAR; PG8_WAIT_L(0); PG8_MMA(0, 1, At, B1); PG8_BAR;
            PG8_LDA(At, 0, 1); PG8_STAGE(PG8_SA(0, 0), a2, voffA);
            PG8_BAR; PG8_WAIT_L(0); PG8_MMA(1, 0, At, B0); PG8_BAR; PG8_SCHED;
            PG8_STAGE(PG8_SB(0, 1), b2 + hstep, voffB);
            PG8_WAIT_V(6); PG8_BAR; PG8_MMA(1, 1, At, B1); PG8_BAR;
            PG8_LDB(B0, 1, 0); PG8_SCHED; PG8_LDA(At, 1, 0); PG8_STAGE(PG8_SA(0, 1), a2 + hstep, voffA);
            PG8_WAIT_L(8); PG8_BAR; PG8_WAIT_L(0); PG8_MMA(0, 0, At, B0); PG8_BAR; PG8_SCHED;
            PG8_LDB(B1, 1, 1); PG8_STAGE(PG8_SB(1, 0), b3, voffB);
            PG8_BAR; PG8_WAIT_L(0); PG8_MMA(0, 1, At, B1); PG8_BAR;
            PG8_LDA(At, 1, 1); PG8_STAGE(PG8_SA(1, 0), a3, voffA);
            PG8_BAR; PG8_WAIT_L(0); PG8_MMA(1, 0, At, B0); PG8_BAR; PG8_SCHED;
            PG8_STAGE(PG8_SB(1, 1), b3 + hstep, voffB);
            PG8_WAIT_V(6); PG8_BAR; PG8_MMA(1, 1, At, B1); PG8_BAR;
            }
        }
        if constexpr (ALIGN_EPI) { if (wr == 0) PG8_BAR; }
        if constexpr (!Epi::AFTER_DRAIN) { E(acc, cur, wr, wc, fr, fq); S.done(cur); }
        if (!has_next) break;
#pragma unroll
        for (int a = 0; a < 2; ++a)
#pragma unroll
            for (int b = 0; b < 2; ++b)
#pragma unroll
                for (int m = 0; m < 4; ++m)
#pragma unroll
                    for (int n = 0; n < 2; ++n) acc[a][b][m][n] = (f32x4){0.f, 0.f, 0.f, 0.f};
        cur = nxt; cA = nA; cB = nB; ++ui;
        if constexpr (ALIGN_EPI) { if (wr == 1) PG8_BAR; }
    }
    PG8_WAIT_V(0);
    if constexpr (!ALIGN_EPI) { if (wr == 0) PG8_BAR; }
    PG8_BAR;
    if constexpr (Epi::AFTER_DRAIN) { E.fused(acc, cur, wr, wc, fr, fq, lds, wid, lane); S.done(cur); }
#undef PG8_SA
#undef PG8_SB
#undef PG8_STAGE
#undef PG8_LDA
#undef PG8_LDB
#undef PG8_MMA
#undef PG8_WAIT_V
#undef PG8_WAIT_L
#undef PG8_BAR
#undef PG8_SCHED
}
}

#define LAS __attribute__((address_space(3)))
typedef unsigned short bf16_t;
typedef short bf16x8 __attribute__((ext_vector_type(8)));
typedef float f32x2 __attribute__((ext_vector_type(2)));
typedef float f32x4 __attribute__((ext_vector_type(4)));
typedef float f32x16 __attribute__((ext_vector_type(16)));
typedef unsigned u32x2 __attribute__((ext_vector_type(2)));
typedef unsigned u32x4 __attribute__((ext_vector_type(4)));
typedef __bf16 bf16x2_t __attribute__((ext_vector_type(2)));

constexpr int NB = 4, SEQ = 2048, DM = 2048, MT = NB * SEQ, DFF = 8192, HW = 6144, INW = 6152, NLAYER = 2;
constexpr float LOG2E = 1.4426950408889634f;
constexpr float C2 = 0.125f * LOG2E;
constexpr float DN_ALPHA = 1.4142135623730951f;
constexpr float LN_EPS = 1e-5f, RMS_EPS = 1e-5f;
constexpr int NWAVES = 8, NTHREADS = 512;
constexpr int LDS_BYTES = 147456;

constexpr size_t MiB = 1u << 20;
constexpr size_t WS_CTL = 0, CTL_BYTES = 32768;
constexpr int CW_BAR = 4096;
constexpr size_t WS_WIN = 2 * MiB, WIN_STRIDE = 24 * MiB;
constexpr size_t WS_WOUT = 50 * MiB, WOUT_STRIDE = 8 * MiB;
constexpr size_t WS_W1 = 66 * MiB, W1_STRIDE = 32 * MiB;
constexpr size_t WS_W2 = 130 * MiB, W2_STRIDE = 32 * MiB;
constexpr size_t WS_WFZ = 194 * MiB;
constexpr size_t WS_FZ = 195 * MiB;
constexpr size_t WS_XB = 196 * MiB;
constexpr size_t WS_XF = 228 * MiB;
constexpr size_t WS_H = 292 * MiB;
constexpr size_t WS_VT = 388 * MiB;
constexpr size_t WS_A2 = 292 * MiB;
constexpr size_t WS_MIX = 420 * MiB;
constexpr size_t WS_END = 452 * MiB;

__device__ __forceinline__ unsigned cvtpk(float lo, float hi) { f32x2 v = {lo, hi}; bf16x2_t b = __builtin_convertvector(v, bf16x2_t); return __builtin_bit_cast(unsigned, b); }
__device__ __forceinline__ float xhalf(float v, int hi) {
    auto rr = __builtin_amdgcn_permlane32_swap(__float_as_uint(v), __float_as_uint(v), false, false);
    return __uint_as_float(hi ? rr[0] : rr[1]);
}
__device__ __forceinline__ float wave_sum(float v) {
#pragma unroll
    for (int o = 1; o < 64; o <<= 1) v += __shfl_xor(v, o);
    return v;
}
__device__ __forceinline__ float ex2(float x) { return __builtin_amdgcn_exp2f(x); }
__device__ __forceinline__ float lg2(float x) { return __builtin_amdgcn_logf(x); }
__device__ __forceinline__ float bf2f(unsigned short b) { return __uint_as_float(((unsigned)b) << 16); }

namespace att {
constexpr int PITCH = 144, KT = 64 * PITCH;
constexpr int L_K0 = 0, L_K1 = KT, L_V0 = 2 * KT, L_V1 = 4 * KT, L_CT = 6 * KT, L_FLAG = L_CT + 8192, L_WSUM = L_FLAG + 128, L_END = L_WSUM + 64;
enum { FOX = 0, SB = 1, DIFF = 2, DIL = 3 };
constexpr bool SB_EARLY = true;
constexpr float SB_CUT = -170.f;

template <int MODE, int DV>
__device__ __forceinline__ void attn_pass(f32x16 (&o)[DV / 32], float& l_out, LAS unsigned char* lds, const bf16_t* __restrict__ Hq, const bf16_t* __restrict__ Hk,
                                          const bf16_t* __restrict__ Vtb, int qb, float slope2) {
    int tid = threadIdx.x; asm volatile("" : "+v"(tid)); const int lane = tid & 63, r32 = lane & 31, hi = lane >> 5, wid = __builtin_amdgcn_readfirstlane(tid >> 6);
    const int q0w = 256 * qb + 32 * wid, tq = q0w + r32;
    bf16x8 qf[4];
#pragma unroll
    for (int d0 = 0; d0 < 4; ++d0) qf[d0] = *(const bf16x8*)(Hq + (size_t)tq * HW + 16 * d0 + 8 * hi);
    const f32x16 zero = {0.f, 0.f, 0.f, 0.f, 0.f, 0.f, 0.f, 0.f, 0.f, 0.f, 0.f, 0.f, 0.f, 0.f, 0.f, 0.f};
#pragma unroll
    for (int db = 0; db < DV / 32; ++db) o[db] = zero;
    const int NT = 4 * (qb + 1), my_last = 4 * qb + (wid >> 1);
    const int srow = tid >> 3, sc = tid & 7;
    const bf16_t* kg = Hk + (size_t)srow * HW + 8 * sc;
    const bf16_t* vg = Vtb + (size_t)lane * HW + 8 * wid;
    const int voff = (8 * wid) * PITCH + (((lane & ~12) | ((lane & 4) << 1) | ((lane & 8) >> 1)) * 2);
    const int soff = srow * PITCH + sc * 16;
    constexpr bool DESC = (MODE == SB);
    const LAS float* ctab = (const LAS float*)(lds + L_CT);
    volatile LAS unsigned* flag = (volatile LAS unsigned*)(lds + L_FLAG);
    float ct2 = 0.f;
    if (MODE == FOX) ct2 = ctab[tq];
    float m = -INFINITY, l = 0.f, R = 0.f;
    u32x4 kreg, vreg0, vreg1 = {0u, 0u, 0u, 0u};
#define ATT_GLOAD(t) do { kreg = *(const u32x4*)(kg + (size_t)(t) * 64 * HW); vreg0 = *(const u32x4*)(vg + (size_t)(t) * 64 * HW); if (DV == 128) vreg1 = *(const u32x4*)(vg + 64 + (size_t)(t) * 64 * HW); } while (0)
#define ATT_LWRITE(buf) do { *(LAS u32x4*)(lds + ((buf) ? L_K1 : L_K0) + soff) = kreg; \
        { const bf16x8 v8 = __builtin_bit_cast(bf16x8, vreg0); LAS unsigned char* vd = lds + ((buf) ? L_V1 : L_V0) + voff; \
          _Pragma("unroll") for (int e = 0; e < 8; ++e) *(LAS short*)(vd + e * PITCH) = v8[e]; } \
        if (DV == 128) { const bf16x8 v8 = __builtin_bit_cast(bf16x8, vreg1); LAS unsigned char* vd = lds + ((buf) ? L_V1 : L_V0) + KT + voff; \
          _Pragma("unroll") for (int e = 0; e < 8; ++e) *(LAS short*)(vd + e * PITCH) = v8[e]; } } while (0)
    { const int t0 = DESC ? NT - 1 : 0; ATT_GLOAD(t0); ATT_LWRITE(0); }
    __syncthreads();
    for (int i = 0; i < NT; ++i) {
        const int t = DESC ? NT - 1 - i : i;
        const bool has_next = (i + 1 < NT);
        const int cur = i & 1;
        if (has_next) { const int tn = DESC ? t - 1 : t + 1; ATT_GLOAD(tn); }
        if (t <= my_last) {
            const LAS unsigned char* kb = lds + (cur ? L_K1 : L_K0) + r32 * PITCH + hi * 16;
            const LAS unsigned char* vb = lds + (cur ? L_V1 : L_V0) + r32 * PITCH + hi * 16;
            f32x16 p[2]; p[0] = zero; p[1] = zero;
#pragma unroll
            for (int d0 = 0; d0 < 4; ++d0)
#pragma unroll
                for (int kh = 0; kh < 2; ++kh) { const bf16x8 kf = *(const LAS bf16x8*)(kb + kh * 32 * PITCH + d0 * 32); p[kh] = __builtin_amdgcn_mfma_f32_32x32x16_bf16(kf, qf[d0], p[kh], 0, 0, 0); }
            const int dl = tq - 64 * t - 4 * hi;
            const bool diag = (64 * t + 63 > q0w);
            if (MODE != SB) {
                if (MODE == FOX) {
#pragma unroll
                    for (int kh = 0; kh < 2; ++kh)
#pragma unroll
                        for (int g = 0; g < 4; ++g) { const f32x4 cs = *(const LAS f32x4*)(ctab + 64 * t + 32 * kh + 8 * g + 4 * hi);
#pragma unroll
                            for (int j = 0; j < 4; ++j) p[kh][4 * g + j] = __builtin_fmaf(p[kh][4 * g + j], C2, ct2 - cs[j]); }
                } else {
                    const float b0 = -slope2 * (float)dl;
#pragma unroll
                    for (int kh = 0; kh < 2; ++kh)
#pragma unroll
                        for (int r = 0; r < 16; ++r) { const int cst = 32 * kh + 8 * (r >> 2) + (r & 3);
                            float x = __builtin_fmaf(p[kh][r], C2, __builtin_fmaf(slope2, (float)cst, b0));
                            if (MODE == DIL) { const int d = dl - cst;
                                const float c = ((d <= 128) ? 1.f : 0.f) + ((((d & 3) == 0) && (d <= 512)) ? 1.f : 0.f) + (((d & 15) == 0) ? 1.f : 0.f);
                                x += lg2(c); }
                            p[kh][r] = x; }
                }
                if (diag) {
#pragma unroll
                    for (int kh = 0; kh < 2; ++kh)
#pragma unroll
                        for (int r = 0; r < 16; ++r) { const int cst = 32 * kh + 8 * (r >> 2) + (r & 3); if (cst > dl) p[kh][r] = -INFINITY; }
                }
                float mx = p[0][0];
#pragma unroll
                for (int kh = 0; kh < 2; ++kh)
#pragma unroll
                    for (int r = 0; r < 16; ++r) mx = __builtin_fmaxf(mx, p[kh][r]);
                mx = __builtin_fmaxf(mx, xhalf(mx, hi));
                const float mnew = __builtin_fmaxf(m, mx);
                const float msub = (mnew == -INFINITY) ? 0.f : mnew;
                const float alpha = ex2(m - msub); m = mnew;
                float rs = 0.f;
#pragma unroll
                for (int kh = 0; kh < 2; ++kh)
#pragma unroll
                    for (int r = 0; r < 16; ++r) { const float e = ex2(p[kh][r] - msub); rs += e; p[kh][r] = e; }
                l = l * alpha + rs;
#pragma unroll
                for (int db = 0; db < DV / 32; ++db) o[db] *= alpha;
            } else {
                f32x16 v[2];
#pragma unroll
                for (int kh = 0; kh < 2; ++kh)
#pragma unroll
                    for (int r = 0; r < 16; ++r) { const int cst = 32 * kh + 8 * (r >> 2) + (r & 3);
                        const float y = p[kh][r] * C2; const float e = ex2(-__builtin_fabsf(y)); const float lb = __builtin_fminf(y, 0.f) - lg2(1.f + e);
                        float lom = lb - y; if (diag && !(cst < dl)) lom = 0.f;
                        p[kh][r] = lb; v[kh][r] = lom; }
                float G[2][4], Hh[2][4], T[2][4];
#pragma unroll
                for (int kh = 0; kh < 2; ++kh)
#pragma unroll
                    for (int g = 0; g < 4; ++g) { G[kh][g] = (v[kh][4 * g] + v[kh][4 * g + 1]) + (v[kh][4 * g + 2] + v[kh][4 * g + 3]); Hh[kh][g] = xhalf(G[kh][g], hi); T[kh][g] = G[kh][g] + Hh[kh][g]; }
                float suf = R;
#pragma unroll
                for (int kk = 0; kk < 2; ++kk) { const int kh = 1 - kk;
#pragma unroll
                    for (int gg = 0; gg < 4; ++gg) { const int g = 3 - gg;
                        const float base = suf + (hi == 0 ? Hh[kh][g] : 0.f);
                        const float l3 = base, l2 = l3 + v[kh][4 * g + 3], l1 = l2 + v[kh][4 * g + 2], l0 = l1 + v[kh][4 * g + 1];
                        p[kh][4 * g + 3] = ex2(p[kh][4 * g + 3] + l3); p[kh][4 * g + 2] = ex2(p[kh][4 * g + 2] + l2);
                        p[kh][4 * g + 1] = ex2(p[kh][4 * g + 1] + l1); p[kh][4 * g + 0] = ex2(p[kh][4 * g + 0] + l0);
                        suf += T[kh][g]; } }
                R = suf;
                if (diag) {
#pragma unroll
                    for (int kh = 0; kh < 2; ++kh)
#pragma unroll
                        for (int r = 0; r < 16; ++r) { const int cst = 32 * kh + 8 * (r >> 2) + (r & 3); if (!(cst < dl)) p[kh][r] = 0.f; }
                }
            }
            bf16x8 pf[4];
#pragma unroll
            for (int s = 0; s < 4; ++s) { const int kh = s >> 1, bs = 8 * (s & 1); u32x4 w;
                w.x = cvtpk(p[kh][bs], p[kh][bs + 1]); w.y = cvtpk(p[kh][bs + 2], p[kh][bs + 3]); w.z = cvtpk(p[kh][bs + 4], p[kh][bs + 5]); w.w = cvtpk(p[kh][bs + 6], p[kh][bs + 7]);
                pf[s] = __builtin_bit_cast(bf16x8, w); }
#pragma unroll
            for (int db = 0; db < DV / 32; ++db)
#pragma unroll
                for (int s = 0; s < 4; ++s) { const bf16x8 vf = *(const LAS bf16x8*)(vb + db * 32 * PITCH + s * 32); o[db] = __builtin_amdgcn_mfma_f32_32x32x16_bf16(vf, pf[s], o[db], 0, 0, 0); }
        }
        if (has_next) ATT_LWRITE(cur ^ 1);
        if (MODE == SB && SB_EARLY) { const int done = __all(R < SB_CUT); if (lane == 0) flag[cur * 8 + wid] = done ? 1u : 0u; }
        __syncthreads();
        if (MODE == SB && SB_EARLY) { unsigned all = 1u;
#pragma unroll
            for (int w = 0; w < 8; ++w) all &= flag[cur * 8 + w];
            if (all) break; }
    }
#undef ATT_GLOAD
#undef ATT_LWRITE
    l_out = l + xhalf(l, hi);
}

template <int NDB>
__device__ __forceinline__ void store_o(const f32x16 (&o)[NDB], bf16_t* dst  , int hi) {
#pragma unroll
    for (int db = 0; db < NDB; ++db)
#pragma unroll
        for (int g = 0; g < 4; ++g) { u32x2 w; w.x = cvtpk(o[db][4 * g], o[db][4 * g + 1]); w.y = cvtpk(o[db][4 * g + 2], o[db][4 * g + 3]);
            *(u32x2*)(dst + 32 * db + 8 * g + 4 * hi) = w; }
}

struct Ctx {
    const bf16_t* H; const bf16_t* Vt; bf16_t* MIX; const float* fz; const float* bf; const float* lq1; const float* lk1; const float* lq2; const float* lk2; const float* subg; float lam_init;
};

__device__ __forceinline__ void unit_fox(const Ctx& C, LAS unsigned char* lds, int b, int h, int qb) {
    int tid = threadIdx.x; asm volatile("" : "+v"(tid)); const int lane = tid & 63, r32 = lane & 31, hi = lane >> 5, wid = __builtin_amdgcn_readfirstlane(tid >> 6);
    { LAS float* ctab = (LAS float*)(lds + L_CT); LAS float* wsum = (LAS float*)(lds + L_WSUM);
      const float bfh = C.bf[h]; float v[4];
#pragma unroll
      for (int j = 0; j < 4; ++j) { const float z = (C.fz[(size_t)(b * SEQ + 4 * tid + j) * 8 + h] + bfh) * LOG2E; v[j] = __builtin_fminf(z, 0.f) - lg2(1.f + ex2(-__builtin_fabsf(z))); }
      v[1] += v[0]; v[2] += v[1]; v[3] += v[2];
      float inc = v[3];
#pragma unroll
      for (int o = 1; o < 64; o <<= 1) { const float n = __shfl_up(inc, o); if (lane >= o) inc += n; }
      if (lane == 63) wsum[wid] = inc;
      __syncthreads();
      float off = inc - v[3];
#pragma unroll
      for (int w = 0; w < 8; ++w) if (w < wid) off += wsum[w];
      *(LAS f32x4*)(ctab + 4 * tid) = (f32x4){off + v[0], off + v[1], off + v[2], off + v[3]};
      __syncthreads(); }
    f32x16 o[2]; float l;
    const bf16_t* Hb = C.H + (size_t)b * SEQ * HW;
    attn_pass<FOX, 64>(o, l, lds, Hb + 64 * h, Hb + 512 + 64 * h, Hb + 1024 + 64 * h, qb, 0.f);
    const float inv = 1.0f / l; o[0] *= inv; o[1] *= inv;
    store_o<2>(o, C.MIX + (size_t)(b * SEQ + 256 * qb + 32 * wid + r32) * DM + 64 * h, hi);
}
__device__ __forceinline__ void unit_sb(const Ctx& C, LAS unsigned char* lds, int b, int h, int qb) {
    int tid = threadIdx.x; asm volatile("" : "+v"(tid)); const int lane = tid & 63, r32 = lane & 31, hi = lane >> 5, wid = __builtin_amdgcn_readfirstlane(tid >> 6);
    f32x16 o[2]; float l;
    const bf16_t* Hb = C.H + (size_t)b * SEQ * HW;
    attn_pass<SB, 64>(o, l, lds, Hb + 1536 + 64 * h, Hb + 2048 + 64 * h, Hb + 2560 + 64 * h, qb, 0.f);
    store_o<2>(o, C.MIX + (size_t)(b * SEQ + 256 * qb + 32 * wid + r32) * DM + 512 + 64 * h, hi);
}
__device__ __forceinline__ void unit_dil(const Ctx& C, LAS unsigned char* lds, int b, int h, int qb) {
    int tid = threadIdx.x; asm volatile("" : "+v"(tid)); const int lane = tid & 63, r32 = lane & 31, hi = lane >> 5, wid = __builtin_amdgcn_readfirstlane(tid >> 6);
    f32x16 o[2]; float l;
    const bf16_t* Hb = C.H + (size_t)b * SEQ * HW;
    const float slope2 = exp2f(-8.0f * (float)(h + 5) / 12.0f) * LOG2E;
    attn_pass<DIL, 64>(o, l, lds, Hb + 4608 + 64 * h, Hb + 5120 + 64 * h, Hb + 5632 + 64 * h, qb, slope2);
    const float inv = 1.0f / l; o[0] *= inv; o[1] *= inv;
    store_o<2>(o, C.MIX + (size_t)(b * SEQ + 256 * qb + 32 * wid + r32) * DM + 1536 + 64 * h, hi);
}
__device__ __forceinline__ void unit_diff(const Ctx& C, LAS unsigned char* lds, int b, int h, int qb) {
    int tid = threadIdx.x; asm volatile("" : "+v"(tid)); const int lane = tid & 63, r32 = lane & 31, hi = lane >> 5, wid = __builtin_amdgcn_readfirstlane(tid >> 6);
    const float s1 = wave_sum(C.lq1[lane] * C.lk1[lane]), s2 = wave_sum(C.lq2[lane] * C.lk2[lane]);
    const float lam = expf(s1) - expf(s2) + C.lam_init;
    const bf16_t* Hb = C.H + (size_t)b * SEQ * HW;
    const bf16_t* Vtb = Hb + 4096 + 128 * h;
    const float slope2 = exp2f(-8.0f * (float)(h + 1) / 12.0f) * LOG2E;
    f32x16 o1[4], o2[4]; float l1, l2;
    attn_pass<DIFF, 128>(o1, l1, lds, Hb + 3072 + 128 * h, Hb + 3584 + 128 * h, Vtb, qb, slope2);
    { const float inv = 1.0f / l1;
#pragma unroll
      for (int db = 0; db < 4; ++db) o1[db] *= inv; }
    attn_pass<DIFF, 128>(o2, l2, lds, Hb + 3072 + 128 * h + 64, Hb + 3584 + 128 * h + 64, Vtb, qb, slope2);
    { const float inv = lam / l2; float ss = 0.f;
#pragma unroll
      for (int db = 0; db < 4; ++db) { o1[db] -= o2[db] * inv;
#pragma unroll
          for (int r = 0; r < 16; ++r) ss += o1[db][r] * o1[db][r]; }
      ss += xhalf(ss, hi);
      const float rn = (1.0f / sqrtf(ss * (1.0f / 128.0f) + RMS_EPS)) * (1.0f - C.lam_init);
#pragma unroll
      for (int db = 0; db < 4; ++db)
#pragma unroll
          for (int g = 0; g < 4; ++g) { const f32x4 gg = *(const f32x4*)(C.subg + 32 * db + 8 * g + 4 * hi);
#pragma unroll
              for (int j = 0; j < 4; ++j) o1[db][4 * g + j] *= rn * gg[j]; } }
    store_o<4>(o1, C.MIX + (size_t)(b * SEQ + 256 * qb + 32 * wid + r32) * DM + 1024 + 128 * h, hi);
}

constexpr int NUNITS = 896;
__device__ __forceinline__ void decode_unit(int u, int& mode, int& b, int& h, int& qb) {
    int r = u; bool isd = false; int q = 0;
    if (r < 96) { isd = true; q = 7 - r / 16; r = r % 16; }
    else { r -= 96;
        if (r < 192) { q = 7 - r / 96; r = r % 96; }
        else { r -= 192;
            if (r < 16) { isd = true; q = 1; }
            else { r -= 16;
                if (r < 288) { q = 5 - r / 96; r = r % 96; }
                else { r -= 288;
                    if (r < 16) { isd = true; q = 0; }
                    else { r -= 16; q = 2 - r / 96; r = r % 96; } } } } }
    qb = q;
    if (isd) { mode = DIFF; b = r >> 2; h = r & 3; }
    else { const int k = r >> 5; mode = (k == 0) ? SB : (k == 1) ? DIL : FOX; b = (r & 31) >> 3; h = r & 7; }
}

__device__ __forceinline__ void attn_phase(const Ctx& C, LAS unsigned char* lds, unsigned* ctr) {
    volatile LAS int* su = (volatile LAS int*)(lds + L_END);
    for (;;) {
        if (threadIdx.x == 0) su[0] = (int)atomicAdd(ctr, 1u);
        __syncthreads();
        const int u = su[0];
        __syncthreads();
        if (u >= NUNITS) break;
        int mode, b, h, qb; decode_unit(u, mode, b, h, qb);
#ifndef NO_DIFF
        if (mode == DIFF) unit_diff(C, lds, b, h, qb);
#endif
#ifndef NO_SB
        if (mode == SB) unit_sb(C, lds, b, h, qb);
#endif
#ifndef NO_DIL
        if (mode == DIL) unit_dil(C, lds, b, h, qb);
#endif
#ifndef NO_FOX
        if (mode == FOX) unit_fox(C, lds, b, h, qb);
#endif
    }
}
}

__device__ __forceinline__ void wt_item(const float* __restrict__ W, int Nsrc, int K, bf16_t* __restrict__ WT, int k0, int n0, int csrc, LAS float* scr, int lane) {
    const int lr = lane >> 4, lc = 4 * (lane & 15);
#pragma unroll 8
    for (int i = 0; i < 16; ++i) { const int kk = 4 * i + lr; const f32x4 v = *(const f32x4*)(W + (size_t)(k0 + kk) * Nsrc + csrc + lc);
        scr[kk * 65 + lc] = v[0]; scr[kk * 65 + lc + 1] = v[1]; scr[kk * 65 + lc + 2] = v[2]; scr[kk * 65 + lc + 3] = v[3]; }
    asm volatile("s_waitcnt lgkmcnt(0)" ::: "memory");
    const int c = lane & 7;
#pragma unroll
    for (int i = 0; i < 8; ++i) { const int n = 8 * i + (lane >> 3); const LAS float* s = scr + (8 * c) * 65 + n;
        u32x4 o; o.x = cvtpk(s[0], s[65]); o.y = cvtpk(s[2 * 65], s[3 * 65]); o.z = cvtpk(s[4 * 65], s[5 * 65]); o.w = cvtpk(s[6 * 65], s[7 * 65]);
        *(u32x4*)(WT + (size_t)(n0 + n) * K + k0 + 8 * c) = o; }
    asm volatile("s_waitcnt lgkmcnt(0)" ::: "memory");
}

struct Args { const float* in[15]; float* out; unsigned char* ws; int ph_lo, ph_hi; };

__device__ __forceinline__ void phase_convert(const Args& a, LAS unsigned char* lds) {
    int tid = threadIdx.x; asm volatile("" : "+v"(tid)); const int lane = tid & 63, wid = tid >> 6;
    const int gw = blockIdx.x * NWAVES + wid, NGW = gridDim.x * NWAVES;
    LAS float* scr = (LAS float*)(lds + wid * 16640);
    constexpr int I_IN = 32 * 96, I_OUT = 32 * 32, I_1 = 32 * 128, I_2 = 128 * 32, I_L = I_IN + I_OUT + I_1 + I_2;
    for (int it = gw; it < NLAYER * I_L; it += NGW) {
        const int l = it / I_L; int r = it % I_L;
        if (r < I_IN) { const int kt = r / 96, nt = r % 96, n0 = 64 * nt; wt_item(a.in[1] + (size_t)l * DM * INW, INW, DM, (bf16_t*)(a.ws + WS_WIN + l * WIN_STRIDE), 64 * kt, n0, n0 + (n0 >= 1536 ? 8 : 0), scr, lane); continue; } r -= I_IN;
        if (r < I_OUT) { const int kt = r / 32, nt = r % 32; wt_item(a.in[8] + (size_t)l * DM * DM, DM, DM, (bf16_t*)(a.ws + WS_WOUT + l * WOUT_STRIDE), 64 * kt, 64 * nt, 64 * nt, scr, lane); continue; } r -= I_OUT;
        if (r < I_1) { const int kt = r / 128, nt = r % 128; wt_item(a.in[11] + (size_t)l * DM * DFF, DFF, DM, (bf16_t*)(a.ws + WS_W1 + l * W1_STRIDE), 64 * kt, 64 * nt, 64 * nt, scr, lane); continue; } r -= I_1;
        { const int kt = r / 32, nt = r % 32; wt_item(a.in[12] + (size_t)l * DFF * DM, DM, DFF, (bf16_t*)(a.ws + WS_W2 + l * W2_STRIDE), 64 * kt, 64 * nt, 64 * nt, scr, lane); }
    }
    const int gt = blockIdx.x * NTHREADS + tid, NGT = gridDim.x * NTHREADS;
    const float* x = a.in[0]; bf16_t* XB = (bf16_t*)(a.ws + WS_XB);
    for (int i = gt; i < MT * DM / 8; i += NGT) { const f32x4 v0 = *(const f32x4*)(x + (size_t)i * 8), v1 = *(const f32x4*)(x + (size_t)i * 8 + 4);
        u32x4 o; o.x = cvtpk(v0[0], v0[1]); o.y = cvtpk(v0[2], v0[3]); o.z = cvtpk(v1[0], v1[1]); o.w = cvtpk(v1[2], v1[3]); *(u32x4*)(XB + (size_t)i * 8) = o; }
    float* wfz = (float*)(a.ws + WS_WFZ);
    for (int i = gt; i < NLAYER * 8 * DM; i += NGT) { const int l = i / (8 * DM), h = (i / DM) & 7, k = i % DM; wfz[i] = a.in[1][((size_t)l * DM + k) * INW + 1536 + h]; }
}

__device__ __forceinline__ void phase_fz(const Args& a, int layer) {
    int tid = threadIdx.x; asm volatile("" : "+v"(tid)); const int lane = tid & 63, wid = tid >> 6;
    const int gw = blockIdx.x * NWAVES + wid, NGW = gridDim.x * NWAVES;
    const bf16_t* XB = (const bf16_t*)(a.ws + WS_XB); const float* wfz = (const float*)(a.ws + WS_WFZ) + (size_t)layer * 8 * DM; float* fz = (float*)(a.ws + WS_FZ);
    for (int m = gw; m < MT; m += NGW) {
        float xv[4][8];
#pragma unroll
        for (int j = 0; j < 4; ++j) { const bf16x8 v = *(const bf16x8*)(XB + (size_t)m * DM + 512 * j + 8 * lane);
#pragma unroll
            for (int e = 0; e < 8; ++e) xv[j][e] = bf2f((unsigned short)v[e]); }
        float mine = 0.f;
#pragma unroll
        for (int h = 0; h < 8; ++h) { float acc = 0.f;
#pragma unroll
            for (int j = 0; j < 4; ++j) { const f32x4 w0 = *(const f32x4*)(wfz + h * DM + 512 * j + 8 * lane), w1 = *(const f32x4*)(wfz + h * DM + 512 * j + 8 * lane + 4);
                acc += xv[j][0] * w0[0] + xv[j][1] * w0[1] + xv[j][2] * w0[2] + xv[j][3] * w0[3] + xv[j][4] * w1[0] + xv[j][5] * w1[1] + xv[j][6] * w1[2] + xv[j][7] * w1[3]; }
            acc = wave_sum(acc); if (lane == h) mine = acc; }
        if (lane < 8) fz[(size_t)m * 8 + lane] = mine;
    }
}

__device__ __forceinline__ void phase_vtrans(const Args& a, LAS unsigned char* lds) {
    int tid = threadIdx.x; asm volatile("" : "+v"(tid)); const int lane = tid & 63, wid = tid >> 6;
    const int gw = blockIdx.x * NWAVES + wid, NGW = gridDim.x * NWAVES;
    const bf16_t* H = (const bf16_t*)(a.ws + WS_H); bf16_t* Vt = (bf16_t*)(a.ws + WS_VT);
    LAS unsigned char* scr = lds + wid * 9216;
    for (int it = gw; it < 4 * 32 * 32; it += NGW) {
        const int b = it >> 10, vb = (it >> 5) & 31, tt = it & 31;
        const int vrow0 = 64 * vb, seg = vrow0 >> 9, col0 = 1024 + 1536 * seg + (vrow0 & 511);
        const int c = lane & 7;
#pragma unroll
        for (int i = 0; i < 8; ++i) { const int tok = 8 * i + (lane >> 3); const int tokp = (tok & ~12) | ((tok & 4) << 1) | ((tok & 8) >> 1);
            const bf16x8 v = *(const bf16x8*)(H + (size_t)(b * SEQ + 64 * tt + tok) * HW + col0 + 8 * c);
#pragma unroll
            for (int e = 0; e < 8; ++e) *(LAS short*)(scr + (8 * c + e) * 144 + tokp * 2) = v[e]; }
        asm volatile("s_waitcnt lgkmcnt(0)" ::: "memory");
#pragma unroll
        for (int i = 0; i < 8; ++i) { const int d = 8 * i + (lane >> 3); const u32x4 v = *(const LAS u32x4*)(scr + d * 144 + c * 16);
            *(u32x4*)(Vt + ((size_t)b * 2048 + vrow0 + d) * SEQ + 64 * tt + 8 * c) = v; }
        asm volatile("s_waitcnt lgkmcnt(0)" ::: "memory");
    }
}

__device__ __forceinline__ void phase_ln(const float* src, float* dst, bf16_t* XB, const float* __restrict__ g, const float* __restrict__ bb) {
    int tid = threadIdx.x; asm volatile("" : "+v"(tid)); const int lane = tid & 63, wid = tid >> 6;
    const int gw = blockIdx.x * NWAVES + wid, NGW = gridDim.x * NWAVES;
    for (int m = gw; m < MT; m += NGW) {
        f32x4 v[8]; float s = 0.f;
#pragma unroll
        for (int j = 0; j < 8; ++j) { v[j] = *(const f32x4*)(src + (size_t)m * DM + 4 * (lane + 64 * j)); s += (v[j][0] + v[j][1]) + (v[j][2] + v[j][3]); }
        const float mean = wave_sum(s) * (1.0f / DM); float q = 0.f;
#pragma unroll
        for (int j = 0; j < 8; ++j) { v[j] = v[j] - mean; q += (v[j][0] * v[j][0] + v[j][1] * v[j][1]) + (v[j][2] * v[j][2] + v[j][3] * v[j][3]); }
        const float rstd = 1.0f / sqrtf(wave_sum(q) * (1.0f / DM) + LN_EPS);
#pragma unroll
        for (int j = 0; j < 8; ++j) { const int cidx = 4 * (lane + 64 * j); const f32x4 gg = *(const f32x4*)(g + cidx), b4 = *(const f32x4*)(bb + cidx);
            const f32x4 y = v[j] * rstd * gg + b4;
            *(f32x4*)(dst + (size_t)m * DM + cidx) = y;
            u32x2 w; w.x = cvtpk(y[0], y[1]); w.y = cvtpk(y[2], y[3]); *(u32x2*)(XB + (size_t)m * DM + cidx) = w; }
    }
}

#define XB_TMO      128
#define XB_XCNT(j)  (256  + 64 * (j))
#define XB_XSUB(j)  (1280 + 64 * (j))
#define XB_XGEN(j)  (2304 + 64 * (j))
#define XB_TOP      3328
#define XB_TOPGEN   3392
#define XCD_BAR_WORDS 3456
#define XB_SPIN_CAP (1u << 18)

__device__ __forceinline__ unsigned xb_ld(unsigned* p)              { return __hip_atomic_load(p, __ATOMIC_RELAXED, __HIP_MEMORY_SCOPE_AGENT); }
__device__ __forceinline__ unsigned xb_add(unsigned* p, unsigned v) { return __hip_atomic_fetch_add(p, v, __ATOMIC_RELAXED, __HIP_MEMORY_SCOPE_AGENT); }
__device__ __forceinline__ unsigned xb_xcc_id() { return (unsigned)__builtin_amdgcn_s_getreg((3 << 11) | 20) & 0xFu; }
#define XB_SPIN(cond, bar) do { unsigned _sp = 0; while (cond) { __builtin_amdgcn_s_sleep(1); \
    if ((++_sp & 255u) == 0u) { if (xb_ld(&(bar)[XB_TMO])) break; if (_sp > XB_SPIN_CAP) { atomicAdd(&(bar)[XB_TMO], 1u); break; } } } } while (0)

struct XcdBarrier {
    unsigned* bar; unsigned x;
    volatile LAS unsigned* st;
};

__device__ __forceinline__ XcdBarrier xcd_barrier_post(unsigned* bar, volatile LAS unsigned* st) {
    XcdBarrier b; b.bar = bar; b.x = xb_xcc_id(); b.st = st;
    if (threadIdx.x == 0) (void)xb_add(&bar[XB_XCNT(b.x)], 1u);
    return b;
}
__device__ __forceinline__ void xcd_barrier_complete(unsigned* bar, unsigned x, unsigned& nloc, unsigned& nx) {
    const unsigned G = gridDim.x * gridDim.y * gridDim.z;
    unsigned sum, cnt, mine, sp = 0u;
    for (;;) {
        sum = 0u; cnt = 0u; mine = 0u;
#pragma unroll
        for (unsigned j = 0; j < 16; ++j) { const unsigned c = xb_ld(&bar[XB_XCNT(j)]); sum += c; cnt += (c > 0u) ? 1u : 0u; mine = (j == x) ? c : mine; }
        if (sum == G) break;
        __builtin_amdgcn_s_sleep(1);
        if ((++sp & 255u) == 0u) { if (xb_ld(&bar[XB_TMO])) break; if (sp > XB_SPIN_CAP) { atomicAdd(&bar[XB_TMO], 1u); break; } }
    }
    nloc = mine > 0u ? mine : 1u; nx = cnt > 0u ? cnt : 1u;
}

__device__ __forceinline__ void xcd_barrier(const XcdBarrier& b) {
    asm volatile("s_waitcnt vmcnt(0)" ::: "memory");
    __syncthreads();
    if (threadIdx.x == 0) {
        unsigned* bar = b.bar;
        __builtin_amdgcn_s_waitcnt(0);
        unsigned nloc = b.st[0], nx = b.st[1];
        if (nloc == 0u) { xcd_barrier_complete(bar, b.x, nloc, nx); b.st[0] = nloc; b.st[1] = nx; }
        const unsigned old = xb_add(&bar[XB_XSUB(b.x)], 1u);
        const unsigned gen = old / nloc;
        if (old + 1u == (gen + 1u) * nloc) {
            __builtin_amdgcn_fence(__ATOMIC_RELEASE, "agent");
            asm volatile("s_waitcnt vmcnt(0)" ::: "memory");
            const unsigned og = xb_add(&bar[XB_TOP], 1u);
            const unsigned tg = og / nx;
            if (og + 1u == (tg + 1u) * nx) xb_add(&bar[XB_TOPGEN], 1u);
            else XB_SPIN(xb_ld(&bar[XB_TOPGEN]) == tg, bar);
            __builtin_amdgcn_fence(__ATOMIC_ACQUIRE, "agent");
            xb_add(&bar[XB_XGEN(b.x)], 1u);
            asm volatile("s_waitcnt vmcnt(0)" ::: "memory");
        } else {
            XB_SPIN(xb_ld(&bar[XB_XGEN(b.x)]) == gen, bar);
            __builtin_amdgcn_fence(__ATOMIC_ACQUIRE, "agent");
            asm volatile("s_waitcnt vmcnt(0)" ::: "memory");
        }
    }
    __syncthreads();
}

#ifndef PHM
#define PHM 511
#endif
#ifndef GSYNC_PH
#define GSYNC_PH 0
#endif
constexpr int PH_PER_LAYER = 7, N_PHASES = 1 + NLAYER * PH_PER_LAYER;

__global__ void __launch_bounds__(NTHREADS, 2) fwd_megakernel(Args a) {
    extern __shared__ __attribute__((aligned(16))) unsigned char lds_raw[];
    LAS unsigned char* lds = (LAS unsigned char*)lds_raw;
    cg::grid_group grid = cg::this_grid();
    unsigned char* ws = a.ws;
    volatile LAS unsigned* bst = (volatile LAS unsigned*)(lds + LDS_BYTES - 64);
    if (threadIdx.x < 16) bst[threadIdx.x] = 0u;
    __syncthreads();
    XcdBarrier xbar = xcd_barrier_post((unsigned*)(ws + WS_CTL) + CW_BAR, bst);
    bf16_t* XB = (bf16_t*)(ws + WS_XB); float* XF = (float*)(ws + WS_XF); bf16_t* Hb = (bf16_t*)(ws + WS_H); bf16_t* MIX = (bf16_t*)(ws + WS_MIX); bf16_t* A2 = (bf16_t*)(ws + WS_A2);
    for (int ph = a.ph_lo; ph < a.ph_hi; ++ph) {
        if (ph == 0) { if (PHM & 1) phase_convert(a, lds);
#ifdef PROBE_CV2
            phase_convert(a, lds);
#endif
        }
        else {
            const int layer = (ph - 1) / PH_PER_LAYER, sub = (ph - 1) % PH_PER_LAYER;
            if (sub == 0 && (PHM & 2)) {
                pg8::Gemm g{XB, (const bf16_t*)(ws + WS_WIN + layer * WIN_STRIDE), MT, HW, DM}; pg8::StaticOrder S; S.init(MT, HW, (int)gridDim.x, (int)blockIdx.x);
                pg8::EpiBf16A<0> E{Hb, HW};
                pg8::gemm_phase<pg8::EpiBf16A<0>, pg8::StaticOrder, true, true>(lds, g, S, E);
#ifdef PROBE_G1
                pg8::gemm_phase<pg8::EpiBf16A<0>, pg8::StaticOrder, true, true>(lds, g, S, E);
#endif
                phase_fz(a, layer);
            } else if (sub == 1 && (PHM & 8)) {
                att::Ctx C; C.H = Hb; C.Vt = (const bf16_t*)(ws + WS_VT); C.MIX = MIX; C.fz = (const float*)(ws + WS_FZ); C.bf = a.in[2] + layer * 8;
                C.lq1 = a.in[3] + layer * 64; C.lk1 = a.in[4] + layer * 64; C.lq2 = a.in[5] + layer * 64; C.lk2 = a.in[6] + layer * 64; C.subg = a.in[7] + layer * 128;
                C.lam_init = 0.8f - 0.6f * expf(-0.3f * (float)layer);
                att::attn_phase(C, lds, (unsigned*)(ws + WS_CTL) + 64 * (1 + layer));
#ifdef PROBE_ATT2
                att::attn_phase(C, lds, (unsigned*)(ws + WS_CTL) + 64 * (5 + layer));
#endif
            } else if (sub == 2 && (PHM & 16)) {
                pg8::Gemm g{MIX, (const bf16_t*)(ws + WS_WOUT + layer * WOUT_STRIDE), MT, DM, DM}; pg8::StaticOrder S; S.init(MT, DM, (int)gridDim.x, (int)blockIdx.x);
                pg8::EpiResF32 E{layer == 0 ? a.in[0] : (const float*)XF, XF, DM, DN_ALPHA};
                pg8::gemm_phase<pg8::EpiResF32, pg8::StaticOrder, true, true>(lds, g, S, E);
            } else if (sub == 3 && (PHM & 32)) { phase_ln(XF, XF, XB, a.in[9] + layer * DM, a.in[10] + layer * DM);
            } else if (sub == 4 && (PHM & 64)) {
                pg8::Gemm g{XB, (const bf16_t*)(ws + WS_W1 + layer * W1_STRIDE), MT, DFF, DM}; pg8::StaticOrder S; S.init(MT, DFF, (int)gridDim.x, (int)blockIdx.x);
                pg8::EpiBf16A<2> E{A2, DFF};
                pg8::gemm_phase<pg8::EpiBf16A<2>, pg8::StaticOrder, true, true>(lds, g, S, E);
#ifdef PROBE_G3
                pg8::gemm_phase<pg8::EpiBf16A<2>, pg8::StaticOrder, true, true>(lds, g, S, E);
#endif
            } else if (sub == 5 && (PHM & 128)) {
                pg8::Gemm g{A2, (const bf16_t*)(ws + WS_W2 + layer * W2_STRIDE), MT, DM, DFF}; pg8::StaticOrder S; S.init(MT, DM, (int)gridDim.x, (int)blockIdx.x);
                pg8::EpiResF32 E{XF, XF, DM, DN_ALPHA};
                pg8::gemm_phase<pg8::EpiResF32, pg8::StaticOrder, true, true>(lds, g, S, E);
            } else if (sub == 6 && (PHM & 256)) { phase_ln(XF, layer == NLAYER - 1 ? a.out : XF, XB, a.in[13] + layer * DM, a.in[14] + layer * DM); }
        }
        if (ph + 1 < a.ph_hi) { if (ph == GSYNC_PH) grid.sync(); else xcd_barrier(xbar); }
    }
}

#ifndef MK_PER_PHASE
#define MK_PER_PHASE 0
#endif
extern "C" void kernel_launch(void* const* d_in, const int* in_sizes, int n_in, void* d_out, int out_size, void* d_ws, size_t ws_size, hipStream_t stream) {
    static int grid = 0;
    if (grid == 0) {
        if (n_in != 15 || in_sizes[0] != MT * DM || out_size != MT * DM || ws_size < WS_END) { fprintf(stderr, "kernel_launch: unexpected shapes / workspace (n_in %d, ws %zu)\n", n_in, ws_size); grid = -1; return; }
        int dev = 0, cus = 0, per_cu = 0;
        (void)hipGetDevice(&dev); (void)hipDeviceGetAttribute(&cus, hipDeviceAttributeMultiprocessorCount, dev);
        if (hipFuncSetAttribute((const void*)fwd_megakernel, hipFuncAttributeMaxDynamicSharedMemorySize, LDS_BYTES) != hipSuccess) { fprintf(stderr, "kernel_launch: hipFuncSetAttribute failed\n"); grid = -1; return; }
        if (hipOccupancyMaxActiveBlocksPerMultiprocessor(&per_cu, (const void*)fwd_megakernel, NTHREADS, LDS_BYTES) != hipSuccess || per_cu < 1) { fprintf(stderr, "kernel_launch: occupancy query says %d blocks per CU\n", per_cu); grid = -1; (void)hipGetLastError(); return; }
        grid = cus;
    }
    if (grid < 0) return;
    (void)hipMemsetAsync((char*)d_ws + WS_CTL, 0, CTL_BYTES, stream);
    Args a{};
    for (int i = 0; i < 15; ++i) a.in[i] = (const float*)d_in[i];
    a.out = (float*)d_out; a.ws = (unsigned char*)d_ws;
#if MK_PER_PHASE
    for (int ph = 0; ph < N_PHASES; ++ph) { a.ph_lo = ph; a.ph_hi = ph + 1; hipLaunchKernelGGL(fwd_megakernel, dim3(grid), dim3(NTHREADS), LDS_BYTES, stream, a); }
#else
    a.ph_lo = 0; a.ph_hi = N_PHASES;
    void* args[] = {&a};
    hipError_t e = hipLaunchCooperativeKernel((void*)fwd_megakernel, dim3(grid), dim3(NTHREADS), args, LDS_BYTES, stream);
    if (e != hipSuccess) fprintf(stderr, "cooperative launch failed: %s (grid %d)\n", hipGetErrorString(e), grid);
#endif
}
```
